# Optimizing an MI355X kernel written in HIP

```python
import math
import jax, jax.numpy as jnp
from jax import lax
import numpy as np

D_MODEL = 1024
BATCH = 8
SEQ = 2048
DEPTH = 1
DEC_BATCH = 128
DEC_SEQ = 1
PAST_LEN = 16384
PAGE_SIZE = 128

GLA_HEADS = 4
GLA_KEY = D_MODEL // 2
GLA_VAL = D_MODEL
GLA_DK = GLA_KEY // GLA_HEADS
GLA_DV = GLA_VAL // GLA_HEADS
GLA_LORA = 16
GLA_TAU = 16.0
GLA_CHUNK = 64
RWKV_HEAD = 64
RWKV_WIDTH = D_MODEL
RWKV_HEADS = RWKV_WIDTH // RWKV_HEAD
RWKV_DECAY_LORA = 64
RWKV_AAA_LORA = 64
RWKV_DECAY_SCALE = 0.606531
GLA_SPLITS = (GLA_KEY, GLA_KEY, GLA_VAL, GLA_VAL, GLA_LORA)
RWKV_SPLITS = (RWKV_WIDTH, RWKV_WIDTH, RWKV_WIDTH, RWKV_WIDTH,
               RWKV_DECAY_LORA, RWKV_AAA_LORA)
GLA_COLS = sum(GLA_SPLITS)
RWKV_COLS = sum(RWKV_SPLITS)
GATE_COLS = 2 * D_MODEL
N_IN = GLA_COLS + RWKV_COLS + GATE_COLS
DEEPNORM_ALPHA = (2.0 * DEPTH) ** 0.25
DEEPNORM_BETA = (8.0 * DEPTH) ** -0.25
LN_EPS = 1e-5
GLA_NORM_EPS = 1e-5
RWKV_GN_EPS = 64e-5
L2_EPS = 1e-12

kernel_name = "gla_rwkv7_gated_hybrid_step"


def _split(x, sizes):
    idx = np.cumsum(np.array(sizes))[:-1].tolist()
    return jnp.split(x, idx, axis=-1)


def _layernorm(x, g, b, eps):
    xf = x.astype(jnp.float32)
    mu = jnp.mean(xf, axis=-1, keepdims=True)
    var = jnp.mean(jnp.square(xf - mu), axis=-1, keepdims=True)
    return ((xf - mu) * lax.rsqrt(var + eps) * g + b).astype(x.dtype)


def _to_chunks(t, C):
    B, T, H, Dd = t.shape
    return t.reshape(B, T // C, C, H, Dd).transpose(1, 0, 3, 2, 4)


def _gla_chunked(q, k, v, log_a, S0):
    B, T = q.shape[0], q.shape[1]
    C = min(GLA_CHUNK, T)
    pad = (-T) % C
    if pad:
        pw = ((0, 0), (0, pad), (0, 0), (0, 0))
        q, k, v, log_a = (jnp.pad(t, pw) for t in (q, k, v, log_a))
    qc, kc, vc, gc = (_to_chunks(t, C) for t in (q, k, v, log_a))
    mask = jnp.tril(jnp.ones((C, C), dtype=bool))[:, :, None]

    def step(S, inp):
        qi, ki, vi, gi = inp
        b = jnp.cumsum(gi, axis=2)
        diff = b[:, :, :, None, :] - b[:, :, None, :, :]
        decay = jnp.exp(jnp.where(mask, diff, -jnp.inf))
        A = jnp.einsum('bhid,bhjd,bhijd->bhij', qi, ki, decay)
        o = jnp.einsum('bhij,bhjv->bhiv', A, vi) + jnp.einsum('bhid,bhdv->bhiv', qi * jnp.exp(b), S)
        b_last = b[:, :, -1:, :]
        S_new = jnp.exp(b_last[:, :, 0, :])[..., None] * S + jnp.einsum(
            'bhjd,bhjv->bhdv', ki * jnp.exp(b_last - b), vi)
        return S_new, o

    S, o = lax.scan(step, S0, (qc, kc, vc, gc))
    n = o.shape[0]
    o = o.transpose(1, 0, 3, 2, 4).reshape(B, n * C, GLA_HEADS, GLA_DV)[:, :T]
    return o, S


def _rwkv7_scan(r, w, k, v, kk, a, S0):
    def step(S, inp):
        rt, wt, kt, vt, kkt, at = inp
        sa = jnp.einsum('bhvk,bhk->bhv', S, -kkt)
        S = S * wt[:, :, None, :] + sa[..., None] * (kkt * at)[:, :, None, :] + vt[..., None] * kt[:, :, None, :]
        y = jnp.einsum('bhvk,bhk->bhv', S, rt)
        return S, y

    xs = tuple(jnp.moveaxis(t, 1, 0) for t in (r, w, k, v, kk, a))
    S, ys = lax.scan(step, S0, xs)
    return jnp.moveaxis(ys, 0, 1), S


def _layer(x, S_gla0, S_rwkv0, shift0, w_in, gla_alpha_w2, gla_alpha_b, gla_norm_w,
           rwkv_mu, rwkv_w0, rwkv_w2, rwkv_a0, rwkv_a2, rwkv_k_k, rwkv_k_a, rwkv_r_k,
           rwkv_lnx_w, rwkv_lnx_b, w_up_gla, w_up_rwkv, w_out, ln_g, ln_b):
    B, T, _ = x.shape
    p = jnp.einsum('btd,dn->btn', x, w_in)
    p_gla, p_rwkv, p_gate = _split(p, (GLA_COLS, RWKV_COLS, GATE_COLS))

    q, k, v, g_a, a_lr = _split(p_gla, GLA_SPLITS)
    log_a = jax.nn.log_sigmoid((jnp.einsum('btr,rk->btk', a_lr, gla_alpha_w2) + gla_alpha_b)
                               .astype(jnp.float32)) / GLA_TAU
    hq = lambda t, d: t.astype(jnp.float32).reshape(B, T, GLA_HEADS, d)
    o_gla, S_gla = _gla_chunked(hq(q, GLA_DK) * (GLA_DK ** -0.5), hq(k, GLA_DK), hq(v, GLA_DV),
                                log_a.reshape(B, T, GLA_HEADS, GLA_DK), S_gla0.astype(jnp.float32))
    o_gla = o_gla * lax.rsqrt(jnp.mean(jnp.square(o_gla), axis=-1, keepdims=True) + GLA_NORM_EPS) * gla_norm_w
    o_gla = o_gla.reshape(B, T, GLA_VAL).astype(x.dtype) * jax.nn.silu(g_a)

    prev = jnp.concatenate([shift0[:, None, :].astype(p_rwkv.dtype), p_rwkv[:, :-1]], axis=1)
    pr = p_rwkv + (prev - p_rwkv) * rwkv_mu
    r, kb, vb, g_b, w_lr, aa_lr = _split(pr, RWKV_SPLITS)
    f32 = lambda t: t.astype(jnp.float32)
    w = jnp.exp(-RWKV_DECAY_SCALE * jax.nn.sigmoid(f32(rwkv_w0 + jnp.einsum('btr,rc->btc', jnp.tanh(w_lr), rwkv_w2))))
    a = jax.nn.sigmoid(f32(rwkv_a0 + jnp.einsum('btr,rc->btc', aa_lr, rwkv_a2)))
    kb = f32(kb)
    hr = lambda t: t.reshape(B, T, RWKV_HEADS, RWKV_HEAD)
    kk = hr(kb * rwkv_k_k)
    kk = kk / jnp.maximum(jnp.sqrt(jnp.sum(jnp.square(kk), axis=-1, keepdims=True)), L2_EPS)
    kb = kb * (1.0 + (a - 1.0) * rwkv_k_a)
    rh, kh, vh = hr(f32(r)), hr(kb), hr(f32(vb))
    y, S_rwkv = _rwkv7_scan(rh, hr(w), kh, vh, kk, hr(a), S_rwkv0.astype(jnp.float32))
    mu = jnp.mean(y, axis=-1, keepdims=True)
    var = jnp.mean(jnp.square(y - mu), axis=-1, keepdims=True)
    y = ((y - mu) * lax.rsqrt(var + RWKV_GN_EPS)).reshape(B, T, RWKV_WIDTH) * rwkv_lnx_w + rwkv_lnx_b
    bonus = jnp.sum(rh * kh * rwkv_r_k, axis=-1, keepdims=True) * vh
    y = y + bonus.reshape(B, T, RWKV_WIDTH)
    o_rwkv = y.astype(x.dtype) * jax.nn.silu(g_b)

    gate_a, gate_b = _split(p_gate, (D_MODEL, D_MODEL))
    m = (jax.nn.sigmoid(gate_a) * jnp.einsum('btc,cd->btd', o_gla, w_up_gla)
         + jax.nn.sigmoid(gate_b) * jnp.einsum('btc,cd->btd', o_rwkv, w_up_rwkv))
    out = jnp.einsum('btd,de->bte', m, w_out)
    y_out = _layernorm(DEEPNORM_ALPHA * x + out, ln_g, ln_b, LN_EPS)
    return y_out, S_gla.astype(S_gla0.dtype), S_rwkv.astype(S_rwkv0.dtype), p_rwkv[:, -1].astype(shift0.dtype)


def setup_inputs(seed: int = 0) -> dict:
    key = jax.random.key(seed)
    ks = jax.random.split(key, 26)
    nrm = lambda k, shape, s: s * jax.random.normal(k, shape, jnp.float32)
    L = DEPTH
    return {
        "x_prompt": nrm(ks[0], (BATCH, SEQ, D_MODEL), 1.0),
        "x_sample": nrm(ks[1], (DEC_BATCH, DEC_SEQ, D_MODEL), 1.0),
        "state_gla": nrm(ks[2], (L, DEC_BATCH, GLA_HEADS, GLA_DK, GLA_DV), 0.5),
        "state_rwkv": nrm(ks[3], (L, DEC_BATCH, RWKV_HEADS, RWKV_HEAD, RWKV_HEAD), 0.3),
        "state_rwkv_shift": nrm(ks[4], (L, DEC_BATCH, RWKV_COLS), 1.0),
        "w_in": nrm(ks[5], (L, D_MODEL, N_IN), D_MODEL ** -0.5),
        "gla_alpha_w2": nrm(ks[6], (L, GLA_LORA, GLA_KEY), GLA_LORA ** -0.5),
        "gla_alpha_b": nrm(ks[7], (L, GLA_KEY), 0.5),
        "gla_norm_w": 1.0 + nrm(ks[8], (L, GLA_DV), 0.05),
        "rwkv_mu": jax.random.uniform(ks[9], (L, RWKV_COLS), jnp.float32),
        "rwkv_w0": nrm(ks[10], (L, RWKV_WIDTH), 0.5),
        "rwkv_w2": nrm(ks[11], (L, RWKV_DECAY_LORA, RWKV_WIDTH), RWKV_DECAY_LORA ** -0.5),
        "rwkv_a0": nrm(ks[12], (L, RWKV_WIDTH), 0.5),
        "rwkv_a2": nrm(ks[13], (L, RWKV_AAA_LORA, RWKV_WIDTH), RWKV_AAA_LORA ** -0.5),
        "rwkv_k_k": 0.85 + nrm(ks[14], (L, RWKV_WIDTH), 0.05),
        "rwkv_k_a": 1.0 + nrm(ks[15], (L, RWKV_WIDTH), 0.05),
        "rwkv_r_k": nrm(ks[16], (L, RWKV_HEADS, RWKV_HEAD), 0.1),
        "rwkv_lnx_w": 1.0 + nrm(ks[17], (L, RWKV_WIDTH), 0.05),
        "rwkv_lnx_b": nrm(ks[18], (L, RWKV_WIDTH), 0.02),
        "w_up_gla": nrm(ks[19], (L, GLA_VAL, D_MODEL), DEEPNORM_BETA * GLA_VAL ** -0.5),
        "w_up_rwkv": nrm(ks[20], (L, RWKV_WIDTH, D_MODEL), DEEPNORM_BETA * RWKV_WIDTH ** -0.5),
        "w_out": nrm(ks[21], (L, D_MODEL, D_MODEL), DEEPNORM_BETA * D_MODEL ** -0.5),
        "ln_g": 1.0 + nrm(ks[22], (L, D_MODEL), 0.05),
        "ln_b": nrm(ks[23], (L, D_MODEL), 0.02),
    }


def reference(x_prompt, x_sample, state_gla, state_rwkv, state_rwkv_shift, w_in, gla_alpha_w2,
              gla_alpha_b, gla_norm_w, rwkv_mu, rwkv_w0, rwkv_w2, rwkv_a0, rwkv_a2, rwkv_k_k,
              rwkv_k_a, rwkv_r_k, rwkv_lnx_w, rwkv_lnx_b, w_up_gla, w_up_rwkv, w_out, ln_g, ln_b):
    B = x_prompt.shape[0]
    hp, hs = x_prompt, x_sample
    gla_p, rwkv_p, shift_p, gla_s, rwkv_s, shift_s = [], [], [], [], [], []
    for l in range(DEPTH):
        lp = (w_in[l], gla_alpha_w2[l], gla_alpha_b[l], gla_norm_w[l], rwkv_mu[l], rwkv_w0[l],
              rwkv_w2[l], rwkv_a0[l], rwkv_a2[l], rwkv_k_k[l], rwkv_k_a[l], rwkv_r_k[l],
              rwkv_lnx_w[l], rwkv_lnx_b[l], w_up_gla[l], w_up_rwkv[l], w_out[l], ln_g[l], ln_b[l])
        z_gla = jnp.zeros((B, GLA_HEADS, GLA_DK, GLA_DV), state_gla.dtype)
        z_rwkv = jnp.zeros((B, RWKV_HEADS, RWKV_HEAD, RWKV_HEAD), state_rwkv.dtype)
        z_shift = jnp.zeros((B, RWKV_COLS), state_rwkv_shift.dtype)
        hp, sg, sr, ss = _layer(hp, z_gla, z_rwkv, z_shift, *lp)
        gla_p.append(sg); rwkv_p.append(sr); shift_p.append(ss)
        hs, sg, sr, ss = _layer(hs, state_gla[l], state_rwkv[l], state_rwkv_shift[l], *lp)
        gla_s.append(sg); rwkv_s.append(sr); shift_s.append(ss)
    return (hp, hs, jnp.stack(gla_p), jnp.stack(rwkv_p), jnp.stack(shift_p),
            jnp.stack(gla_s), jnp.stack(rwkv_s), jnp.stack(shift_s))
```

```cpp
#include <hip/hip_runtime.h>
#include <hip/hip_cooperative_groups.h>
#include <cstdio>
namespace cg = cooperative_groups;

#ifndef ONE_LAUNCH
#define ONE_LAUNCH 0
#endif

typedef unsigned short bf16_t;
typedef short bf16x8 __attribute__((ext_vector_type(8)));
typedef float f32x16 __attribute__((ext_vector_type(16)));
typedef float f32x4 __attribute__((ext_vector_type(4)));
typedef float f32x2 __attribute__((ext_vector_type(2)));
typedef unsigned u32x4 __attribute__((ext_vector_type(4)));
typedef unsigned u32x2 __attribute__((ext_vector_type(2)));
#define DI __device__ __forceinline__
#define MFMA(a, b, c) __builtin_amdgcn_mfma_f32_32x32x16_bf16((a), (b), (c), 0, 0, 0)

constexpr int NT = 512;
constexpr int TP = 16384, TT = 16512;
constexpr int LDP = 7424;
constexpr int GQ = 0, GK = 512, GV = 1024, GG = 2048, GA = 3072;
constexpr int RW = 3200;
constexpr int RR = RW, RK = RW + 1024, RV = RW + 2048, RG = RW + 3072, RWL = RW + 4096, RAL = RW + 4160;
constexpr int GATE = 7424;
constexpr int NTILE_N1 = 37, NTILE_M = 129;
constexpr size_t O_YP = 0, O_GLAP = 16908288, O_RWKVP = 17956864, O_SHP = 18481152, O_GLAS = 18514944,
                 O_RWKVS = 35292160, O_SHS = 43680768;

struct Params {
  const float *x_prompt, *x_sample, *state_gla, *state_rwkv, *state_shift, *w_in, *gla_w2, *gla_b, *gla_nw, *mu,
      *w0, *w2, *a0, *a2, *k_k, *k_a, *r_k, *lnx_w, *lnx_b, *w_upg, *w_upr, *w_out, *ln_g, *ln_b;
  float* out;
  bf16_t *P, *Wupg, *Wupr, *Wout, *xb, *Wtin, *SG;
};

DI float bf2f(bf16_t u) { return __uint_as_float((unsigned)u << 16); }
DI float bflo(unsigned u) { return __uint_as_float(u << 16); }
DI float bfhi(unsigned u) { return __uint_as_float(u & 0xffff0000u); }
DI unsigned pk2(float lo, float hi) { unsigned r; asm("v_cvt_pk_bf16_f32 %0, %1, %2" : "=v"(r) : "v"(lo), "v"(hi)); return r; }
DI bf16_t f2bf(float x) { return (bf16_t)(pk2(x, x) & 0xffffu); }
DI float sigm(float x) { return 1.f / (1.f + __expf(-x)); }
DI float silu(float x) { return x / (1.f + __expf(-x)); }
DI float logsig(float x) { return fminf(x, 0.f) - __logf(1.f + __expf(-fabsf(x))); }
DI float tanh_(float x) { float e = __expf(2.f * x); return 1.f - 2.f / (e + 1.f); }
DI void unpack8(u32x4 v, float (&f)[8]) {
  f[0] = bflo(v[0]); f[1] = bfhi(v[0]); f[2] = bflo(v[1]); f[3] = bfhi(v[1]);
  f[4] = bflo(v[2]); f[5] = bfhi(v[2]); f[6] = bflo(v[3]); f[7] = bfhi(v[3]);
}
DI u32x4 pack8(const float (&f)[8]) { u32x4 o = {pk2(f[0], f[1]), pk2(f[2], f[3]), pk2(f[4], f[5]), pk2(f[6], f[7])}; return o; }
DI void ld8f(const float* p, float (&f)[8]) {
  f32x4 a = *(const f32x4*)p, b = *(const f32x4*)(p + 4);
  f[0] = a[0]; f[1] = a[1]; f[2] = a[2]; f[3] = a[3]; f[4] = b[0]; f[5] = b[1]; f[6] = b[2]; f[7] = b[3];
}
DI float red8(float x) {
  x += __builtin_bit_cast(float, __builtin_amdgcn_update_dpp(0, __builtin_bit_cast(int, x), 0xB1, 0xF, 0xF, true));
  x += __builtin_bit_cast(float, __builtin_amdgcn_update_dpp(0, __builtin_bit_cast(int, x), 0x4E, 0xF, 0xF, true));
  x += __builtin_bit_cast(float, __builtin_amdgcn_update_dpp(0, __builtin_bit_cast(int, x), 0x141, 0xF, 0xF, true));
  return x;
}
DI float red64(float x) {
  for (int o = 32; o > 0; o >>= 1) x += __shfl_xor(x, o);
  return x;
}
DI int crow(int reg, int h) { return (reg & 3) + 8 * (reg >> 2) + 4 * h; }
DI bf16x8 pack_acc(const f32x16& x, int s) {
  u32x4 p = {pk2(x[8 * s + 0], x[8 * s + 1]), pk2(x[8 * s + 2], x[8 * s + 3]), pk2(x[8 * s + 4], x[8 * s + 5]), pk2(x[8 * s + 6], x[8 * s + 7])};
  return __builtin_bit_cast(bf16x8, p);
}

__device__ void phase0(const Params& P, char* smem) {
  const int tid = threadIdx.x, nb = gridDim.x, bid = blockIdx.x;
  for (int i = bid * NT + tid; i < TT * 128; i += nb * NT) {
    const int row = i >> 7, c8 = (i & 127) * 8;
    const float* src = row < TP ? P.x_prompt + (size_t)row * 1024 + c8 : P.x_sample + (size_t)(row - TP) * 1024 + c8;
    float f[8]; ld8f(src, f);
    *(u32x4*)(P.xb + (size_t)row * 1024 + c8) = pack8(f);
  }
  float* tile = (float*)smem;
  const int njobs = 16 * 148 + 3 * 256;
  for (int j = bid; j < njobs; j += nb) {
    const float* src; bf16_t* dst; int ldsrc, k0, n0; bool isin;
    if (j < 16 * 148) { isin = true; src = P.w_in; ldsrc = 9360; dst = P.Wtin; k0 = (j & 15) * 64; n0 = (j >> 4) * 64; }
    else { int jj = j - 16 * 148; const int w = jj >> 8; jj &= 255; isin = false; ldsrc = 1024;
      src = w == 0 ? P.w_upg : (w == 1 ? P.w_upr : P.w_out); dst = w == 0 ? P.Wupg : (w == 1 ? P.Wupr : P.Wout);
      k0 = (jj & 15) * 64; n0 = (jj >> 4) * 64; }
#pragma unroll
    for (int it = 0; it < 2; ++it) {
      const int kk = (tid >> 4) + 32 * it, nn = (tid & 15) * 4; const int np = n0 + nn; int n = np;
      if (isin) n = np < 3088 ? np : (np < 3200 ? -1 : np - 112);
      f32x4 v = {0.f, 0.f, 0.f, 0.f};
      if (n >= 0) v = *(const f32x4*)(src + (size_t)(k0 + kk) * ldsrc + n);
      tile[kk * 65 + nn] = v[0]; tile[kk * 65 + nn + 1] = v[1]; tile[kk * 65 + nn + 2] = v[2]; tile[kk * 65 + nn + 3] = v[3];
    }
    __syncthreads();
    { const int nn = tid >> 3, ks = (tid & 7) * 8; float f[8];
#pragma unroll
      for (int e = 0; e < 8; ++e) f[e] = tile[(ks + e) * 65 + nn];
      *(u32x4*)(dst + (size_t)(n0 + nn) * 1024 + k0 + ks) = pack8(f); }
    __syncthreads();
  }
}

constexpr int ROWB = 144;
constexpr int AS_BYTES = 128 * ROWB, BS_BYTES = 256 * ROWB, BUF_BYTES = AS_BYTES + BS_BYTES;

DI void gemm_load(u32x4 (&ra)[2], u32x4 (&rb)[4], const bf16_t* A, int lda, const bf16_t* Bt, int ldb, int row0, int col0, int k0, int tid) {
#pragma unroll
  for (int i = 0; i < 2; ++i) { const int c = tid + NT * i, r = c >> 3, kc = (c & 7) * 8; ra[i] = *(const u32x4*)(A + (size_t)(row0 + r) * lda + k0 + kc); }
#pragma unroll
  for (int i = 0; i < 4; ++i) { const int c = tid + NT * i, r = c >> 3, kc = (c & 7) * 8; rb[i] = *(const u32x4*)(Bt + (size_t)(col0 + r) * ldb + k0 + kc); }
}
DI void gemm_store(char* buf, const u32x4 (&ra)[2], const u32x4 (&rb)[4], int tid) {
#pragma unroll
  for (int i = 0; i < 2; ++i) { const int c = tid + NT * i, r = c >> 3, kc = (c & 7) * 8; *(u32x4*)(buf + r * ROWB + kc * 2) = ra[i]; }
#pragma unroll
  for (int i = 0; i < 4; ++i) { const int c = tid + NT * i, r = c >> 3, kc = (c & 7) * 8; *(u32x4*)(buf + AS_BYTES + r * ROWB + kc * 2) = rb[i]; }
}
DI void gemm_compute(f32x16 (&acc)[2][2], const char* buf, int wm, int wn, int lane) {
  const char* ap = buf + (wm * 64 + (lane & 31)) * ROWB + (lane >> 5) * 16;
  const char* bp = buf + AS_BYTES + (wn * 64 + (lane & 31)) * ROWB + (lane >> 5) * 16;
#pragma unroll
  for (int ks = 0; ks < 4; ++ks) {
    const bf16x8 a0 = *(const bf16x8*)(ap + ks * 32), a1 = *(const bf16x8*)(ap + 32 * ROWB + ks * 32);
    const bf16x8 b0 = *(const bf16x8*)(bp + ks * 32), b1 = *(const bf16x8*)(bp + 32 * ROWB + ks * 32);
    acc[0][0] = MFMA(b0, a0, acc[0][0]); acc[0][1] = MFMA(b1, a0, acc[0][1]);
    acc[1][0] = MFMA(b0, a1, acc[1][0]); acc[1][1] = MFMA(b1, a1, acc[1][1]);
  }
}
DI void gemm_kloop(f32x16 (&acc)[2][2], const bf16_t* A, int lda, const bf16_t* Bt, int ldb, int K, int row0, int col0, char* smem) {
  const int tid = threadIdx.x, lane = tid & 63, wid = tid >> 6, wm = wid >> 2, wn = wid & 3;
  u32x4 ra[2], rb[4];
  gemm_load(ra, rb, A, lda, Bt, ldb, row0, col0, 0, tid);
  gemm_store(smem, ra, rb, tid);
  __syncthreads();
  const int nk = K >> 6;
  for (int kt = 0; kt < nk; ++kt) {
    char* cur = smem + (kt & 1) * BUF_BYTES; char* nxt = smem + ((kt + 1) & 1) * BUF_BYTES;
    if (kt + 1 < nk) gemm_load(ra, rb, A, lda, Bt, ldb, row0, col0, (kt + 1) * 64, tid);
    gemm_compute(acc, cur, wm, wn, lane);
    if (kt + 1 < nk) gemm_store(nxt, ra, rb, tid);
    __syncthreads();
  }
}
DI void zero_acc(f32x16 (&acc)[2][2]) {
#pragma unroll
  for (int i = 0; i < 2; ++i)
#pragma unroll
    for (int j = 0; j < 2; ++j)
#pragma unroll
      for (int e = 0; e < 16; ++e) acc[i][j][e] = 0.f;
}

__device__ void phase1(const Params& P, char* smem) {
  const int tid = threadIdx.x, lane = tid & 63, wid = tid >> 6, wm = wid >> 2, wn = wid & 3, h = lane >> 5;
  for (int t = blockIdx.x; t < NTILE_M * NTILE_N1; t += gridDim.x) {
    int pm, pn; const int g = t / 592;
    if (g < 8) { const int r = t - g * 592; pn = r >> 4; pm = g * 16 + (r & 15); } else { pm = 128; pn = t - 8 * 592; }
    f32x16 acc[2][2]; zero_acc(acc);
    gemm_kloop(acc, P.xb, 1024, P.Wtin, 1024, 1024, pm * 128, pn * 256, smem);
#pragma unroll
    for (int mi = 0; mi < 2; ++mi)
#pragma unroll
      for (int ni = 0; ni < 2; ++ni) {
        const int row = pm * 128 + wm * 64 + mi * 32 + (lane & 31);
        const int cb = pn * 256 + wn * 64 + ni * 32 + 4 * h;
#pragma unroll
        for (int g4 = 0; g4 < 4; ++g4) {
          const int col = cb + 8 * g4;
          const float v0 = acc[mi][ni][4 * g4], v1 = acc[mi][ni][4 * g4 + 1], v2 = acc[mi][ni][4 * g4 + 2], v3 = acc[mi][ni][4 * g4 + 3];
          if (cb < GATE) {
            u32x2 o = {pk2(v0, v1), pk2(v2, v3)};
            *(u32x2*)(P.P + (size_t)row * LDP + col) = o;
            if (cb >= RW) {
              f32x4 v = {v0, v1, v2, v3};
              if (row >= TP) *(f32x4*)(P.out + O_SHS + (size_t)(row - TP) * 4224 + (col - RW)) = v;
              else if ((row & 2047) == 2047) *(f32x4*)(P.out + O_SHP + (size_t)(row >> 11) * 4224 + (col - RW)) = v;
            }
          } else {
            u32x2 o = {pk2(sigm(v0), sigm(v1)), pk2(sigm(v2), sigm(v3))};
            *(u32x2*)(P.SG + (size_t)row * 2048 + (col - GATE)) = o;
          }
        }
      }
  }
}

constexpr int G_QT = 0, G_KT = 17408, G_KHT = 34816, G_VT = 53248, G_AM = 90112, G_ALR = 99328, G_BL = 103424, G_SEG = 103936, G_SSQ = 105984;
__device__ void gla_prompt_unit(const Params& P, char* smem, int b, int hd) {
  const int tid = threadIdx.x, lane = tid & 63, wid = tid >> 6, h = lane >> 5, l31 = lane & 31;
  bf16_t* QT = (bf16_t*)(smem + G_QT); bf16_t* KT = (bf16_t*)(smem + G_KT);
  float* ALR = (float*)(smem + G_ALR); float* BL = (float*)(smem + G_BL); float* SEG = (float*)(smem + G_SEG); float* SSQ = (float*)(smem + G_SSQ);
  const int dk = tid & 127, seg = tid >> 7;
  float w2c[16];
#pragma unroll
  for (int j = 0; j < 16; ++j) w2c[j] = P.gla_w2[j * 512 + hd * 128 + dk];
  const float bias = P.gla_b[hd * 128 + dk];
  f32x16 S[4];
#pragma unroll
  for (int kb = 0; kb < 4; ++kb)
#pragma unroll
    for (int e = 0; e < 16; ++e) S[kb][e] = 0.f;
  const float qscale = 0.08838834764831845f;

  for (int c = 0; c < 32; ++c) {
    const size_t rb = (size_t)b * 2048 + c * 64;
    if (tid < 256) { const int i = tid >> 2, j4 = (tid & 3) * 4;
      const u32x2 v = *(const u32x2*)(P.P + (rb + i) * LDP + GA + j4);
      f32x4 f = {bflo(v[0]), bfhi(v[0]), bflo(v[1]), bfhi(v[1])};
      *(f32x4*)(ALR + i * 16 + j4) = f; }
    __syncthreads();
    float bc[16]; float run = 0.f;
#pragma unroll
    for (int ii = 0; ii < 16; ++ii) {
      const int i = 16 * seg + ii; float x = bias;
#pragma unroll
      for (int j4 = 0; j4 < 4; ++j4) { const f32x4 a = *(const f32x4*)(ALR + i * 16 + 4 * j4);
        x += a[0] * w2c[4 * j4] + a[1] * w2c[4 * j4 + 1] + a[2] * w2c[4 * j4 + 2] + a[3] * w2c[4 * j4 + 3]; }
      run += logsig(x) * 0.0625f; bc[ii] = run;
    }
    SEG[seg * 128 + dk] = run;
    __syncthreads();
    float off = 0.f, tot = 0.f;
#pragma unroll
    for (int s = 0; s < 4; ++s) { const float v = SEG[s * 128 + dk]; tot += v; if (s < seg) off += v; }
    if (seg == 0) BL[dk] = tot;
    { float kh[16];
#pragma unroll
      for (int ii = 0; ii < 16; ++ii) {
        const int i = 16 * seg + ii; const float bb = bc[ii] + off;
        const float q = bf2f(P.P[(rb + i) * LDP + GQ + hd * 128 + dk]), k = bf2f(P.P[(rb + i) * LDP + GK + hd * 128 + dk]);
        QT[i * 136 + dk] = f2bf(q * qscale * __expf(bb));
        KT[i * 136 + dk] = f2bf(k * __expf(-bb));
        kh[ii] = k * __expf(tot - bb);
      }
      u32x4 o0 = {pk2(kh[0], kh[1]), pk2(kh[2], kh[3]), pk2(kh[4], kh[5]), pk2(kh[6], kh[7])};
      u32x4 o1 = {pk2(kh[8], kh[9]), pk2(kh[10], kh[11]), pk2(kh[12], kh[13]), pk2(kh[14], kh[15])};
      *(u32x4*)(smem + G_KHT + dk * ROWB + seg * 32) = o0; *(u32x4*)(smem + G_KHT + dk * ROWB + seg * 32 + 16) = o1; }
    { const int dv = tid & 255, half = tid >> 8;
#pragma unroll
      for (int q4 = 0; q4 < 4; ++q4) { unsigned w[4];
#pragma unroll
        for (int e = 0; e < 4; ++e) { const int i = 32 * half + 8 * q4 + 2 * e;
          const unsigned lo = P.P[(rb + i) * LDP + GV + hd * 256 + dv], hi = P.P[(rb + i + 1) * LDP + GV + hd * 256 + dv];
          w[e] = lo | (hi << 16); }
        u32x4 o = {w[0], w[1], w[2], w[3]};
        *(u32x4*)(smem + G_VT + dv * ROWB + half * 64 + q4 * 16) = o; } }
    __syncthreads();
    f32x16 o[2];
#pragma unroll
    for (int ib = 0; ib < 2; ++ib)
#pragma unroll
      for (int e = 0; e < 16; ++e) o[ib][e] = 0.f;
#pragma unroll
    for (int kb = 0; kb < 4; ++kb)
#pragma unroll
      for (int s = 0; s < 2; ++s) {
        const bf16x8 sp = pack_acc(S[kb], s);
#pragma unroll
        for (int ib = 0; ib < 2; ++ib) {
          const char* qp = smem + G_QT + (32 * ib + l31) * 272 + (32 * kb + 16 * s + 4 * h) * 2;
          const u32x2 q0 = *(const u32x2*)qp, q1 = *(const u32x2*)(qp + 16);
          u32x4 qq = {q0[0], q0[1], q1[0], q1[1]};
          o[ib] = MFMA(sp, __builtin_bit_cast(bf16x8, qq), o[ib]);
        }
      }
    if (wid < 4) {
      const int bi = wid >> 1, bj = wid & 1;
      f32x16 am;
#pragma unroll
      for (int e = 0; e < 16; ++e) am[e] = 0.f;
      if (wid != 1) {
#pragma unroll
        for (int ks = 0; ks < 8; ++ks) {
          const bf16x8 qf = *(const bf16x8*)(smem + G_QT + (32 * bi + l31) * 272 + ks * 32 + h * 16);
          const bf16x8 kf = *(const bf16x8*)(smem + G_KT + (32 * bj + l31) * 272 + ks * 32 + h * 16);
          am = MFMA(kf, qf, am);
        }
      }
      const int i = 32 * bi + l31;
#pragma unroll
      for (int g4 = 0; g4 < 4; ++g4) { float v[4];
#pragma unroll
        for (int e = 0; e < 4; ++e) { const int j = 32 * bj + 8 * g4 + 4 * h + e; v[e] = (j <= i) ? am[4 * g4 + e] : 0.f; }
        u32x2 ov = {pk2(v[0], v[1]), pk2(v[2], v[3])};
        *(u32x2*)(smem + G_AM + i * ROWB + (32 * bj + 8 * g4 + 4 * h) * 2) = ov; }
    }
    __syncthreads();
    { bf16x8 vf[4];
#pragma unroll
      for (int ks = 0; ks < 4; ++ks) vf[ks] = *(const bf16x8*)(smem + G_VT + (32 * wid + l31) * ROWB + ks * 32 + h * 16);
#pragma unroll
      for (int ib = 0; ib < 2; ++ib)
#pragma unroll
        for (int ks = 0; ks < 4; ++ks) { const bf16x8 af = *(const bf16x8*)(smem + G_AM + (32 * ib + l31) * ROWB + ks * 32 + h * 16);
          o[ib] = MFMA(vf[ks], af, o[ib]); }
#pragma unroll
      for (int kb = 0; kb < 4; ++kb) {
#pragma unroll
        for (int g4 = 0; g4 < 4; ++g4) { const f32x4 bl = *(const f32x4*)(BL + 32 * kb + 8 * g4 + 4 * h);
#pragma unroll
          for (int e = 0; e < 4; ++e) S[kb][4 * g4 + e] *= __expf(bl[e]); }
#pragma unroll
        for (int ks = 0; ks < 4; ++ks) { const bf16x8 kf = *(const bf16x8*)(smem + G_KHT + (32 * kb + l31) * ROWB + ks * 32 + h * 16);
          S[kb] = MFMA(kf, vf[ks], S[kb]); }
      } }
#pragma unroll
    for (int ib = 0; ib < 2; ++ib) { float s = 0.f;
#pragma unroll
      for (int e = 0; e < 16; ++e) s += o[ib][e] * o[ib][e];
      s += __shfl_xor(s, 32);
      if (lane < 32) SSQ[wid * 64 + 32 * ib + lane] = s; }
    __syncthreads();
#pragma unroll
    for (int ib = 0; ib < 2; ++ib)
#pragma unroll
      for (int g4 = 0; g4 < 4; ++g4) { u32x2 ov = {pk2(o[ib][4 * g4], o[ib][4 * g4 + 1]), pk2(o[ib][4 * g4 + 2], o[ib][4 * g4 + 3])};
        *(u32x2*)(smem + (32 * ib + l31) * 528 + (32 * wid + 8 * g4 + 4 * h) * 2) = ov; }
    __syncthreads();
    { const int i = tid >> 3, sg8 = tid & 7; float ss = 0.f;
#pragma unroll
      for (int w = 0; w < 8; ++w) ss += SSQ[w * 64 + i];
      const float rs = rsqrtf(ss * (1.f / 256.f) + 1e-5f);
#pragma unroll
      for (int q4 = 0; q4 < 4; ++q4) { const int dv0 = 32 * sg8 + 8 * q4;
        float ov[8], gv[8], nw[8];
        unpack8(*(const u32x4*)(smem + i * 528 + dv0 * 2), ov);
        bf16_t* gp = P.P + (rb + i) * LDP + GG + hd * 256 + dv0;
        unpack8(*(const u32x4*)gp, gv);
        ld8f(P.gla_nw + dv0, nw);
#pragma unroll
        for (int e = 0; e < 8; ++e) ov[e] = ov[e] * rs * nw[e] * silu(gv[e]);
        *(u32x4*)gp = pack8(ov); } }
  }
#pragma unroll
  for (int kb = 0; kb < 4; ++kb)
#pragma unroll
    for (int e = 0; e < 16; ++e)
      P.out[O_GLAP + ((size_t)(b * 4 + hd) * 128 + 32 * kb + crow(e, h)) * 256 + 32 * wid + l31] = S[kb][e];
  __syncthreads();
}

constexpr int R_KK = 0, R_WR = 16384, R_KA = 32768, R_KP = 49152, R_VV = 65536, R_Y = 81920, R_LW = 98304, R_GB = 114688, R_W2T = 122880, R_A2T = 132096,
              R_C = 141312, R_CARRY = 142336, R_SEGT = 142848;
__device__ void rwkv_prompt_unit(const Params& P, char* smem, int b, int hd) {
  const int tid = threadIdx.x, lane = tid & 63, wid = tid >> 6, h = lane >> 5, l31 = lane & 31;
  float* KKp = (float*)(smem + R_KK); float* WRp = (float*)(smem + R_WR); float* KAp = (float*)(smem + R_KA); float* Kp = (float*)(smem + R_KP);
  float* Vv = (float*)(smem + R_VV); float* Y = (float*)(smem + R_Y); float* LW = (float*)(smem + R_LW); bf16_t* GB = (bf16_t*)(smem + R_GB);
  float* C3 = (float*)(smem + R_C); float* CARRY = (float*)(smem + R_CARRY); float* SEGT = (float*)(smem + R_SEGT);
  const int t = tid >> 3, cg8 = tid & 7, c8 = cg8 * 8, hc = hd * 64 + c8;
  { const int j = tid >> 3; float f[8], g[8];
    ld8f(P.w2 + j * 1024 + hc, f); ld8f(P.a2 + j * 1024 + hc, g);
#pragma unroll
    for (int e = 0; e < 8; ++e) { *(bf16_t*)(smem + R_W2T + (c8 + e) * ROWB + j * 2) = f2bf(f[e]); *(bf16_t*)(smem + R_A2T + (c8 + e) * ROWB + j * 2) = f2bf(g[e]); } }
  if (tid < 128) CARRY[tid] = 0.f;
  f32x2 S[4];
#pragma unroll
  for (int i = 0; i < 4; ++i) { S[i][0] = 0.f; S[i][1] = 0.f; }
  float mur[8], muk[8], muv[8], mug[8], w0v[8], a0v[8], kkw[8], kaw[8], rkw[8], lnw[8], lnb[8];
  ld8f(P.mu + hc, mur); ld8f(P.mu + 1024 + hc, muk); ld8f(P.mu + 2048 + hc, muv); ld8f(P.mu + 3072 + hc, mug);
  ld8f(P.w0 + hc, w0v); ld8f(P.a0 + hc, a0v); ld8f(P.k_k + hc, kkw); ld8f(P.k_a + hc, kaw); ld8f(P.r_k + hc, rkw);
  ld8f(P.lnx_w + hc, lnw); ld8f(P.lnx_b + hc, lnb);
  __syncthreads();

  for (int c = 0; c < 32; ++c) {
    const size_t rb = (size_t)b * 2048 + c * 64;
    const size_t r = rb + t;
    const bool first = (c == 0 && t == 0);
    { float pw[8], pa[8], qw[8], qa[8], mw[8], ma[8];
      unpack8(*(const u32x4*)(P.P + r * LDP + RWL + c8), pw); unpack8(*(const u32x4*)(P.P + r * LDP + RAL + c8), pa);
      if (!first) { unpack8(*(const u32x4*)(P.P + (r - 1) * LDP + RWL + c8), qw); unpack8(*(const u32x4*)(P.P + (r - 1) * LDP + RAL + c8), qa); }
      else {
#pragma unroll
        for (int e = 0; e < 8; ++e) { qw[e] = 0.f; qa[e] = 0.f; } }
      ld8f(P.mu + 4096 + c8, mw); ld8f(P.mu + 4160 + c8, ma);
#pragma unroll
      for (int e = 0; e < 8; ++e) { pw[e] = tanh_(pw[e] + (qw[e] - pw[e]) * mw[e]); pa[e] = pa[e] + (qa[e] - pa[e]) * ma[e]; }
      *(u32x4*)(smem + R_KK + t * ROWB + c8 * 2) = pack8(pw); *(u32x4*)(smem + R_WR + t * ROWB + c8 * 2) = pack8(pa); }
    __syncthreads();
    { const int w4 = wid & 3, mi = w4 >> 1, ni = w4 & 1; const int abase = wid < 4 ? R_KK : R_WR, bbase = wid < 4 ? R_W2T : R_A2T;
      f32x16 d;
#pragma unroll
      for (int e = 0; e < 16; ++e) d[e] = 0.f;
#pragma unroll
      for (int ks = 0; ks < 4; ++ks) {
        const bf16x8 af = *(const bf16x8*)(smem + abase + (32 * mi + l31) * ROWB + ks * 32 + h * 16);
        const bf16x8 bf = *(const bf16x8*)(smem + bbase + (32 * ni + l31) * ROWB + ks * 32 + h * 16);
        d = MFMA(af, bf, d);
      }
      __syncthreads();
      float* dst = wid < 4 ? Y : LW;
#pragma unroll
      for (int e = 0; e < 16; ++e) dst[(32 * mi + crow(e, h)) * 64 + 32 * ni + l31] = d[e]; }
    __syncthreads();
    float rr[8], kk[8], kka[8], km[8], lw[8];
    { float pr[8], pk[8], pv[8], pg[8], qr[8], qk[8], qv[8], qg[8];
      unpack8(*(const u32x4*)(P.P + r * LDP + RR + hc), pr); unpack8(*(const u32x4*)(P.P + r * LDP + RK + hc), pk);
      unpack8(*(const u32x4*)(P.P + r * LDP + RV + hc), pv); unpack8(*(const u32x4*)(P.P + r * LDP + RG + hc), pg);
      if (!first) { unpack8(*(const u32x4*)(P.P + (r - 1) * LDP + RR + hc), qr); unpack8(*(const u32x4*)(P.P + (r - 1) * LDP + RK + hc), qk);
        unpack8(*(const u32x4*)(P.P + (r - 1) * LDP + RV + hc), qv); }
      else {
#pragma unroll
        for (int e = 0; e < 8; ++e) { qr[e] = 0.f; qk[e] = 0.f; qv[e] = 0.f; } }
      if (t == 0) {
#pragma unroll
        for (int e = 0; e < 8; ++e) qg[e] = CARRY[(c & 1) * 64 + c8 + e]; }
      else unpack8(*(const u32x4*)(P.P + (r - 1) * LDP + RG + hc), qg);
      if (t == 63) {
#pragma unroll
        for (int e = 0; e < 8; ++e) CARRY[((c + 1) & 1) * 64 + c8 + e] = pg[e]; }
      float ssq = 0.f, s1 = 0.f, s2 = 0.f, s3 = 0.f; float vv[8], gg[8];
#pragma unroll
      for (int e = 0; e < 8; ++e) {
        rr[e] = pr[e] + (qr[e] - pr[e]) * mur[e];
        const float kb = pk[e] + (qk[e] - pk[e]) * muk[e];
        vv[e] = pv[e] + (qv[e] - pv[e]) * muv[e];
        gg[e] = pg[e] + (qg[e] - pg[e]) * mug[e];
        const float wa = Y[t * 64 + c8 + e] + w0v[e];
        lw[e] = -0.606531f * sigm(wa);
        const float a = sigm(LW[t * 64 + c8 + e] + a0v[e]);
        kk[e] = kb * kkw[e]; ssq += kk[e] * kk[e];
        km[e] = kb * (1.f + (a - 1.f) * kaw[e]);
        kka[e] = a;
        s3 += rr[e] * km[e] * rkw[e];
        s2 += km[e] * rr[e];
      }
      ssq = red8(ssq);
      const float inv = 1.f / fmaxf(sqrtf(ssq), 1e-12f);
#pragma unroll
      for (int e = 0; e < 8; ++e) { kk[e] *= inv; kka[e] *= kk[e]; s1 += kka[e] * rr[e]; }
      s1 = red8(s1); s2 = red8(s2); s3 = red8(s3);
      if (cg8 == 0) { C3[t * 4] = s1; C3[t * 4 + 1] = s2; C3[t * 4 + 2] = s3; }
#pragma unroll
      for (int e = 0; e < 8; ++e) { LW[t * 64 + c8 + e] = lw[e]; Vv[t * 64 + c8 + e] = vv[e]; }
      *(u32x4*)(smem + R_GB + t * 128 + c8 * 2) = pack8(gg);
    }
    __syncthreads();
    { const int cc = tid & 63, ts = tid >> 6; float run = 0.f;
#pragma unroll
      for (int e = 0; e < 8; ++e) { run += LW[(8 * ts + e) * 64 + cc]; LW[(8 * ts + e) * 64 + cc] = run; }
      SEGT[ts * 64 + cc] = run;
      __syncthreads();
      float off = 0.f;
      for (int s = 0; s < ts; ++s) off += SEGT[s * 64 + cc];
#pragma unroll
      for (int e = 0; e < 8; ++e) LW[(8 * ts + e) * 64 + cc] += off; }
    __syncthreads();
#pragma unroll
    for (int e = 0; e < 8; ++e) {
      const float cum = LW[t * 64 + c8 + e], cprev = cum - lw[e];
      const float Ct = __expf(cum), Cp = __expf(cprev), iC = __expf(-cum);
      KKp[t * 64 + c8 + e] = -kk[e] * Cp; WRp[t * 64 + c8 + e] = rr[e] * Ct; KAp[t * 64 + c8 + e] = kka[e] * iC; Kp[t * 64 + c8 + e] = km[e] * iC;
    }
    __syncthreads();
    { const int row = t;
      for (int tt = 0; tt < 64; ++tt) {
        const f32x4 k0 = *(const f32x4*)(KKp + tt * 64 + c8), k1 = *(const f32x4*)(KKp + tt * 64 + c8 + 4);
        const f32x4 w0_ = *(const f32x4*)(WRp + tt * 64 + c8), w1_ = *(const f32x4*)(WRp + tt * 64 + c8 + 4);
        const f32x4 a0_ = *(const f32x4*)(KAp + tt * 64 + c8), a1_ = *(const f32x4*)(KAp + tt * 64 + c8 + 4);
        const f32x4 p0 = *(const f32x4*)(Kp + tt * 64 + c8), p1 = *(const f32x4*)(Kp + tt * 64 + c8 + 4);
        const float vv = Vv[tt * 64 + row]; const f32x2 c12 = *(const f32x2*)(C3 + tt * 4);
        f32x2 d1 = S[0] * (f32x2){k0[0], k0[1]}; d1 += S[1] * (f32x2){k0[2], k0[3]}; d1 += S[2] * (f32x2){k1[0], k1[1]}; d1 += S[3] * (f32x2){k1[2], k1[3]};
        f32x2 d2 = S[0] * (f32x2){w0_[0], w0_[1]}; d2 += S[1] * (f32x2){w0_[2], w0_[3]}; d2 += S[2] * (f32x2){w1_[0], w1_[1]}; d2 += S[3] * (f32x2){w1_[2], w1_[3]};
        const float sa = red8(d1[0] + d1[1]); const float yp = red8(d2[0] + d2[1]);
        const f32x2 sa2 = {sa, sa}, vv2 = {vv, vv};
        S[0] += sa2 * (f32x2){a0_[0], a0_[1]} + vv2 * (f32x2){p0[0], p0[1]};
        S[1] += sa2 * (f32x2){a0_[2], a0_[3]} + vv2 * (f32x2){p0[2], p0[3]};
        S[2] += sa2 * (f32x2){a1_[0], a1_[1]} + vv2 * (f32x2){p1[0], p1[1]};
        S[3] += sa2 * (f32x2){a1_[2], a1_[3]} + vv2 * (f32x2){p1[2], p1[3]};
        if (cg8 == 0) Y[tt * 64 + row] = yp + sa * c12[0] + vv * c12[1];
      }
#pragma unroll
      for (int i = 0; i < 4; ++i) { S[i][0] *= __expf(LW[63 * 64 + c8 + 2 * i]); S[i][1] *= __expf(LW[63 * 64 + c8 + 2 * i + 1]); } }
    __syncthreads();
    { float y[8]; ld8f(Y + t * 64 + c8, y); float s = 0.f;
#pragma unroll
      for (int e = 0; e < 8; ++e) s += y[e];
      const float mean = red8(s) * (1.f / 64.f); float q = 0.f;
#pragma unroll
      for (int e = 0; e < 8; ++e) { y[e] -= mean; q += y[e] * y[e]; }
      const float rs = rsqrtf(red8(q) * (1.f / 64.f) + 64e-5f);
      const float c3 = C3[t * 4 + 2]; float gg[8], vv[8];
      unpack8(*(const u32x4*)(smem + R_GB + t * 128 + c8 * 2), gg); ld8f(Vv + t * 64 + c8, vv);
#pragma unroll
      for (int e = 0; e < 8; ++e) y[e] = (y[e] * rs * lnw[e] + lnb[e] + c3 * vv[e]) * silu(gg[e]);
      *(u32x4*)(P.P + r * LDP + RG + hc) = pack8(y); }
  }
  { float* dst = P.out + O_RWKVP + ((size_t)(b * 16 + hd) * 64 + t) * 64 + c8;
    f32x4 o0 = {S[0][0], S[0][1], S[1][0], S[1][1]}, o1 = {S[2][0], S[2][1], S[3][0], S[3][1]};
    *(f32x4*)dst = o0; *(f32x4*)(dst + 4) = o1; }
  __syncthreads();
}

__device__ void gla_sample_unit(const Params& P, char* smem, int sb, int hd) {
  const int tid = threadIdx.x;
  float* AD = (float*)smem; float* Qs = AD + 128; float* Ks = Qs + 128; float* Vs = Ks + 128; float* OP = Vs + 256; float* RED = OP + 2048;
  const size_t r = (size_t)TP + sb;
  if (tid < 128) { const int dk = tid; float x = P.gla_b[hd * 128 + dk];
    for (int j = 0; j < 16; ++j) x += bf2f(P.P[r * LDP + GA + j]) * P.gla_w2[j * 512 + hd * 128 + dk];
    AD[dk] = __expf(logsig(x) * 0.0625f);
    Qs[dk] = bf2f(P.P[r * LDP + GQ + hd * 128 + dk]) * 0.08838834764831845f; Ks[dk] = bf2f(P.P[r * LDP + GK + hd * 128 + dk]); }
  else if (tid < 384) { const int dv = tid - 128; Vs[dv] = bf2f(P.P[r * LDP + GV + hd * 256 + dv]); }
  __syncthreads();
  { const int dv4 = (tid & 63) * 4, ds = tid >> 6; f32x4 oacc = {0.f, 0.f, 0.f, 0.f}; const f32x4 v4 = *(const f32x4*)(Vs + dv4);
    const size_t base = ((size_t)(sb * 4 + hd) * 128) * 256;
#pragma unroll 4
    for (int e = 0; e < 16; ++e) { const int dk = 16 * ds + e;
      const f32x4 s4 = *(const f32x4*)(P.state_gla + base + (size_t)dk * 256 + dv4);
      const f32x4 sn = s4 * AD[dk] + v4 * Ks[dk];
      *(f32x4*)(P.out + O_GLAS + base + (size_t)dk * 256 + dv4) = sn;
      oacc += sn * Qs[dk]; }
    *(f32x4*)(OP + ds * 256 + dv4) = oacc; }
  __syncthreads();
  float ov = 0.f;
  if (tid < 256) { for (int s = 0; s < 8; ++s) ov += OP[s * 256 + tid]; const float q = red64(ov * ov); if ((tid & 63) == 0) RED[tid >> 6] = q; }
  __syncthreads();
  if (tid < 256) { const float rs = rsqrtf((RED[0] + RED[1] + RED[2] + RED[3]) * (1.f / 256.f) + 1e-5f);
    bf16_t* gp = P.P + r * LDP + GG + hd * 256 + tid;
    *gp = f2bf(ov * rs * P.gla_nw[tid] * silu(bf2f(*gp))); }
  __syncthreads();
}

__device__ void rwkv_sample_unit(const Params& P, char* smem, int sb, int hd) {
  const int tid = threadIdx.x;
  float* LWv = (float*)smem; float* LAv = LWv + 64; float* KK = LAv + 64; float* WW = KK + 64; float* KA = WW + 64; float* KM = KA + 64;
  float* RRv = KM + 64; float* VVv = RRv + 64; float* GBv = VVv + 64; float* Yv = GBv + 64; float* BON = Yv + 64;
  const size_t r = (size_t)TP + sb; const float* sh = P.state_shift + (size_t)sb * 4224;
  if (tid < 64) { const int j = tid;
    const float pw = bf2f(P.P[r * LDP + RWL + j]), pa = bf2f(P.P[r * LDP + RAL + j]);
    LWv[j] = tanh_(pw + (sh[4096 + j] - pw) * P.mu[4096 + j]); LAv[j] = pa + (sh[4160 + j] - pa) * P.mu[4160 + j]; }
  __syncthreads();
  if (tid < 64) { const int cl = tid, c = hd * 64 + cl;
    float wa = P.w0[c], aa = P.a0[c];
    for (int j = 0; j < 64; ++j) { wa += LWv[j] * P.w2[j * 1024 + c]; aa += LAv[j] * P.a2[j * 1024 + c]; }
    const float pr = bf2f(P.P[r * LDP + RR + c]), pk = bf2f(P.P[r * LDP + RK + c]), pv = bf2f(P.P[r * LDP + RV + c]), pg = bf2f(P.P[r * LDP + RG + c]);
    const float rr = pr + (sh[c] - pr) * P.mu[c], kb = pk + (sh[1024 + c] - pk) * P.mu[1024 + c];
    const float vv = pv + (sh[2048 + c] - pv) * P.mu[2048 + c], gg = pg + (sh[3072 + c] - pg) * P.mu[3072 + c];
    const float w = __expf(-0.606531f * sigm(wa)), a = sigm(aa);
    float kk = kb * P.k_k[c]; const float nrm = sqrtf(red64(kk * kk)); kk = kk / fmaxf(nrm, 1e-12f);
    const float km = kb * (1.f + (a - 1.f) * P.k_a[c]);
    const float bon = red64(rr * km * P.r_k[c]);
    KK[cl] = -kk; WW[cl] = w; KA[cl] = kk * a; KM[cl] = km; RRv[cl] = rr; VVv[cl] = vv; GBv[cl] = gg; if (cl == 0) BON[0] = bon; }
  __syncthreads();
  { const int row = tid >> 3, c8 = (tid & 7) * 8; const size_t base = ((size_t)(sb * 16 + hd) * 64 + row) * 64 + c8;
    float s[8]; ld8f(P.state_rwkv + base, s); float d = 0.f;
#pragma unroll
    for (int e = 0; e < 8; ++e) d += s[e] * KK[c8 + e];
    const float sa = red8(d); const float vv = VVv[row]; float y = 0.f;
#pragma unroll
    for (int e = 0; e < 8; ++e) { s[e] = s[e] * WW[c8 + e] + sa * KA[c8 + e] + vv * KM[c8 + e]; y += s[e] * RRv[c8 + e]; }
    f32x4 o0 = {s[0], s[1], s[2], s[3]}, o1 = {s[4], s[5], s[6], s[7]};
    *(f32x4*)(P.out + O_RWKVS + base) = o0; *(f32x4*)(P.out + O_RWKVS + base + 4) = o1;
    y = red8(y); if ((tid & 7) == 0) Yv[row] = y; }
  __syncthreads();
  if (tid < 64) { const int c = hd * 64 + tid; const float y = Yv[tid]; const float mean = red64(y) * (1.f / 64.f); const float dd = y - mean;
    const float var = red64(dd * dd) * (1.f / 64.f);
    const float o = (dd * rsqrtf(var + 64e-5f) * P.lnx_w[c] + P.lnx_b[c] + BON[0] * VVv[tid]) * silu(GBv[tid]);
    P.P[r * LDP + RG + c] = f2bf(o); }
  __syncthreads();
}

__device__ void phase2(const Params& P, char* smem) {
  const int bid = blockIdx.x;
  if (bid < 128) rwkv_prompt_unit(P, smem, bid >> 4, bid & 15);
  else if (bid < 160) gla_prompt_unit(P, smem, (bid - 128) >> 2, (bid - 128) & 3);
  else {
    const int nbk = gridDim.x - 160;
    for (int u = bid - 160; u < 512; u += nbk) gla_sample_unit(P, smem, u >> 2, u & 3);
    for (int u = bid - 160; u < 2048; u += nbk) rwkv_sample_unit(P, smem, u >> 4, u & 15);
  }
}

__device__ void phase3a(const Params& P, char* smem) {
  const int tid = threadIdx.x, lane = tid & 63, wid = tid >> 6, wm = wid >> 2, wn = wid & 3, h = lane >> 5;
  for (int t = blockIdx.x; t < NTILE_M * 4; t += gridDim.x) {
    const int pm = t >> 2, pn = t & 3;
    f32x16 acc[2][2]; zero_acc(acc);
#pragma unroll 1
    for (int g = 0; g < 2; ++g) {
      gemm_kloop(acc, P.P + (g ? RG : GG), LDP, g ? P.Wupr : P.Wupg, 1024, 1024, pm * 128, pn * 256, smem);
#pragma unroll
      for (int mi = 0; mi < 2; ++mi)
#pragma unroll
        for (int ni = 0; ni < 2; ++ni) {
          const int row = pm * 128 + wm * 64 + mi * 32 + (lane & 31);
          const int cb = pn * 256 + wn * 64 + ni * 32 + 4 * h;
#pragma unroll
          for (int g4 = 0; g4 < 4; ++g4) { const int col = cb + 8 * g4;
            const u32x2 gb = *(const u32x2*)(P.SG + (size_t)row * 2048 + 1024 + col);
            if (g == 0) {
              const u32x2 ga = *(const u32x2*)(P.SG + (size_t)row * 2048 + col);
              acc[mi][ni][4 * g4] *= bflo(ga[0]) / bflo(gb[0]); acc[mi][ni][4 * g4 + 1] *= bfhi(ga[0]) / bfhi(gb[0]);
              acc[mi][ni][4 * g4 + 2] *= bflo(ga[1]) / bflo(gb[1]); acc[mi][ni][4 * g4 + 3] *= bfhi(ga[1]) / bfhi(gb[1]);
            } else {
              u32x2 o = {pk2(bflo(gb[0]) * acc[mi][ni][4 * g4], bfhi(gb[0]) * acc[mi][ni][4 * g4 + 1]),
                         pk2(bflo(gb[1]) * acc[mi][ni][4 * g4 + 2], bfhi(gb[1]) * acc[mi][ni][4 * g4 + 3])};
              *(u32x2*)(P.P + (size_t)row * LDP + col) = o; }
          }
        }
    }
  }
}
__device__ void phase3b(const Params& P, char* smem) {
  const int tid = threadIdx.x, lane = tid & 63, wid = tid >> 6, wm = wid >> 2, wn = wid & 3, h = lane >> 5;
  for (int t = blockIdx.x; t < NTILE_M * 4; t += gridDim.x) {
    const int pm = t >> 2, pn = t & 3;
    f32x16 acc[2][2]; zero_acc(acc);
    gemm_kloop(acc, P.P, LDP, P.Wout, 1024, 1024, pm * 128, pn * 256, smem);
#pragma unroll
    for (int mi = 0; mi < 2; ++mi)
#pragma unroll
      for (int ni = 0; ni < 2; ++ni) {
        const int row = pm * 128 + wm * 64 + mi * 32 + (lane & 31);
        const int cb = pn * 256 + wn * 64 + ni * 32 + 4 * h;
        const float* xr = row < TP ? P.x_prompt + (size_t)row * 1024 : P.x_sample + (size_t)(row - TP) * 1024;
#pragma unroll
        for (int g4 = 0; g4 < 4; ++g4) { const int col = cb + 8 * g4;
          const f32x4 x4 = *(const f32x4*)(xr + col);
          f32x4 z = {acc[mi][ni][4 * g4], acc[mi][ni][4 * g4 + 1], acc[mi][ni][4 * g4 + 2], acc[mi][ni][4 * g4 + 3]};
          z += x4 * 1.189207115002721f;
          *(f32x4*)(P.out + O_YP + (size_t)row * 1024 + col) = z; }
      }
  }
}
__device__ void phase3c(const Params& P) {
  const int tid = threadIdx.x, lane = tid & 63, wid = tid >> 6;
  for (int row = blockIdx.x * 8 + wid; row < TT; row += gridDim.x * 8) {
    float* yr = P.out + O_YP + (size_t)row * 1024;
    f32x4 v[4]; float s = 0.f;
#pragma unroll
    for (int q = 0; q < 4; ++q) { v[q] = *(const f32x4*)(yr + q * 256 + lane * 4); s += v[q][0] + v[q][1] + v[q][2] + v[q][3]; }
    const float mean = red64(s) * (1.f / 1024.f); float qq = 0.f;
#pragma unroll
    for (int q = 0; q < 4; ++q) { v[q] -= mean; qq += v[q][0] * v[q][0] + v[q][1] * v[q][1] + v[q][2] * v[q][2] + v[q][3] * v[q][3]; }
    const float rs = rsqrtf(red64(qq) * (1.f / 1024.f) + 1e-5f);
#pragma unroll
    for (int q = 0; q < 4; ++q) { const f32x4 g = *(const f32x4*)(P.ln_g + q * 256 + lane * 4), bb = *(const f32x4*)(P.ln_b + q * 256 + lane * 4);
      *(f32x4*)(yr + q * 256 + lane * 4) = v[q] * rs * g + bb; }
  }
}

constexpr int SMEM_BYTES = 147456;

#if ONE_LAUNCH
__global__ void __launch_bounds__(NT) fwd_megakernel(Params P) {
  extern __shared__ __attribute__((aligned(16))) char smem[];
  cg::grid_group grid = cg::this_grid();
  phase0(P, smem); grid.sync();
  phase1(P, smem); grid.sync();
  phase2(P, smem); grid.sync();
  phase3a(P, smem); grid.sync();
  phase3b(P, smem); grid.sync();
  phase3c(P);
}
#else
__global__ void __launch_bounds__(NT) k_phase0(Params P) { extern __shared__ __attribute__((aligned(16))) char smem[]; phase0(P, smem); }
__global__ void __launch_bounds__(NT) k_phase1(Params P) { extern __shared__ __attribute__((aligned(16))) char smem[]; phase1(P, smem); }
__global__ void __launch_bounds__(NT) k_phase2(Params P) { extern __shared__ __attribute__((aligned(16))) char smem[]; phase2(P, smem); }
__global__ void __launch_bounds__(NT) k_phase3a(Params P) { extern __shared__ __attribute__((aligned(16))) char smem[]; phase3a(P, smem); }
__global__ void __launch_bounds__(NT) k_phase3b(Params P) { extern __shared__ __attribute__((aligned(16))) char smem[]; phase3b(P, smem); }
__global__ void __launch_bounds__(NT) k_phase3c(Params P) { phase3c(P); }
#endif

extern "C" void kernel_launch(void* const* d_in, const int* in_sizes, int n_in, void* d_out, int out_size, void* d_ws, size_t ws_size,
                              hipStream_t stream) {
  Params P{};
  const float* const* in = (const float* const*)d_in;
  P.x_prompt = in[0]; P.x_sample = in[1]; P.state_gla = in[2]; P.state_rwkv = in[3]; P.state_shift = in[4]; P.w_in = in[5];
  P.gla_w2 = in[6]; P.gla_b = in[7]; P.gla_nw = in[8]; P.mu = in[9]; P.w0 = in[10]; P.w2 = in[11]; P.a0 = in[12]; P.a2 = in[13];
  P.k_k = in[14]; P.k_a = in[15]; P.r_k = in[16]; P.lnx_w = in[17]; P.lnx_b = in[18]; P.w_upg = in[19]; P.w_upr = in[20]; P.w_out = in[21];
  P.ln_g = in[22]; P.ln_b = in[23];
  P.out = (float*)d_out;
  char* ws = (char*)d_ws;
  P.P = (bf16_t*)ws;
  const size_t psz = (size_t)TT * LDP * 2;
  P.Wupg = (bf16_t*)(ws + psz); P.Wupr = P.Wupg + 1024 * 1024; P.Wout = P.Wupr + 1024 * 1024;
  P.xb = (bf16_t*)((float*)d_out + O_GLAS);
  P.Wtin = P.xb + (size_t)TT * 1024;
  P.SG = (bf16_t*)d_out;
#if ONE_LAUNCH
  static int grid_blocks = 0;
  if (!grid_blocks) {
    hipFuncSetAttribute((const void*)fwd_megakernel, hipFuncAttributeMaxDynamicSharedMemorySize, SMEM_BYTES);
    int dev = 0, cus = 0, per_cu = 0;
    hipGetDevice(&dev);
    hipDeviceGetAttribute(&cus, hipDeviceAttributeMultiprocessorCount, dev);
    hipOccupancyMaxActiveBlocksPerMultiprocessor(&per_cu, fwd_megakernel, NT, SMEM_BYTES);
    if (per_cu < 1) per_cu = 1;
    grid_blocks = cus;
    if (grid_blocks < 192) grid_blocks = 192;
  }
  void* args[] = {&P};
  hipError_t e = hipLaunchCooperativeKernel((const void*)fwd_megakernel, dim3(grid_blocks), dim3(NT), args, SMEM_BYTES, stream);
  if (e != hipSuccess) fprintf(stderr, "cooperative launch failed: %s (grid %d)\n", hipGetErrorString(e), grid_blocks);
#else
  static bool init = false;
  if (!init) { init = true;
    hipFuncSetAttribute((const void*)k_phase0, hipFuncAttributeMaxDynamicSharedMemorySize, SMEM_BYTES);
    hipFuncSetAttribute((const void*)k_phase1, hipFuncAttributeMaxDynamicSharedMemorySize, SMEM_BYTES);
    hipFuncSetAttribute((const void*)k_phase2, hipFuncAttributeMaxDynamicSharedMemorySize, SMEM_BYTES);
    hipFuncSetAttribute((const void*)k_phase3a, hipFuncAttributeMaxDynamicSharedMemorySize, SMEM_BYTES);
    hipFuncSetAttribute((const void*)k_phase3b, hipFuncAttributeMaxDynamicSharedMemorySize, SMEM_BYTES);
  }
  k_phase0<<<256, NT, SMEM_BYTES, stream>>>(P);
  k_phase1<<<256, NT, SMEM_BYTES, stream>>>(P);
  k_phase2<<<256, NT, SMEM_BYTES, stream>>>(P);
  k_phase3a<<<256, NT, SMEM_BYTES, stream>>>(P);
  k_phase3b<<<256, NT, SMEM_BYTES, stream>>>(P);
  k_phase3c<<<256, NT, 0, stream>>>(P);
#endif
}
```

```cpp
#include <hip/hip_runtime.h>
#include <hip/hip_cooperative_groups.h>
#include <cstdio>
namespace cg = cooperative_groups;

#ifndef ONE_LAUNCH
#define ONE_LAUNCH 1
#endif

typedef unsigned short bf16_t;
typedef short bf16x8 __attribute__((ext_vector_type(8)));
typedef float f32x16 __attribute__((ext_vector_type(16)));
typedef float f32x4 __attribute__((ext_vector_type(4)));
typedef float f32x2 __attribute__((ext_vector_type(2)));
typedef unsigned u32x4 __attribute__((ext_vector_type(4)));
typedef unsigned u32x2 __attribute__((ext_vector_type(2)));
#define DI __device__ __forceinline__
#define MFMA(a, b, c) __builtin_amdgcn_mfma_f32_32x32x16_bf16((a), (b), (c), 0, 0, 0)

constexpr int NT = 512;
constexpr int SMEM_BYTES = 157696;
constexpr int TP = 16384, TT = 16512;
constexpr int LDP = 7424;
constexpr int GQ = 0, GK = 512, GV = 1024, GG = 2048, GA = 3072;
constexpr int RW = 3200;
constexpr int RR = RW, RK = RW + 1024, RV = RW + 2048, RG = RW + 3072, RWL = RW + 4096, RAL = RW + 4160;
constexpr int GATE = 7424;
constexpr int NTILE_N1 = 37, NTILE_M = 129;
constexpr size_t O_YP = 0, O_GLAP = 16908288, O_RWKVP = 17956864, O_SHP = 18481152, O_GLAS = 18514944,
                 O_RWKVS = 35292160, O_SHS = 43680768;

struct Params {
  const float *x_prompt, *x_sample, *state_gla, *state_rwkv, *state_shift, *w_in, *gla_w2, *gla_b, *gla_nw, *mu,
      *w0, *w2, *a0, *a2, *k_k, *k_a, *r_k, *lnx_w, *lnx_b, *w_upg, *w_upr, *w_out, *ln_g, *ln_b;
  float* out;
  bf16_t *P, *Wupg, *Wupr, *Wout, *xb, *Wtin, *SG;
  unsigned* ctr;
};

DI int tid_() { int t = threadIdx.x; asm volatile("" : "+v"(t)); return t; }
DI float bf2f(bf16_t u) { return __uint_as_float((unsigned)u << 16); }
DI float bflo(unsigned u) { return __uint_as_float(u << 16); }
DI float bfhi(unsigned u) { return __uint_as_float(u & 0xffff0000u); }
typedef __bf16 bf16x2_t __attribute__((ext_vector_type(2)));
DI unsigned pk2(float lo, float hi) { f32x2 v = {lo, hi}; return __builtin_bit_cast(unsigned, __builtin_convertvector(v, bf16x2_t)); }
DI bf16_t f2bf(float x) { return (bf16_t)(pk2(x, x) & 0xffffu); }
DI float sigm(float x) { return __builtin_amdgcn_rcpf(1.f + __expf(-x)); }
DI float silu(float x) { return x * __builtin_amdgcn_rcpf(1.f + __expf(-x)); }
DI float logsig(float x) { return fminf(x, 0.f) - __logf(1.f + __expf(-fabsf(x))); }
DI float tanh_(float x) { float e = __expf(2.f * x); return 1.f - 2.f * __builtin_amdgcn_rcpf(e + 1.f); }
DI void unpack8(u32x4 v, float (&f)[8]) {
  f[0] = bflo(v[0]); f[1] = bfhi(v[0]); f[2] = bflo(v[1]); f[3] = bfhi(v[1]);
  f[4] = bflo(v[2]); f[5] = bfhi(v[2]); f[6] = bflo(v[3]); f[7] = bfhi(v[3]);
}
DI u32x4 pack8(const float (&f)[8]) { u32x4 o = {pk2(f[0], f[1]), pk2(f[2], f[3]), pk2(f[4], f[5]), pk2(f[6], f[7])}; return o; }
DI void ld8f(const float* p, float (&f)[8]) {
  f32x4 a = *(const f32x4*)p, b = *(const f32x4*)(p + 4);
  f[0] = a[0]; f[1] = a[1]; f[2] = a[2]; f[3] = a[3]; f[4] = b[0]; f[5] = b[1]; f[6] = b[2]; f[7] = b[3];
}
DI float red8(float x) {
  x += __builtin_bit_cast(float, __builtin_amdgcn_update_dpp(0, __builtin_bit_cast(int, x), 0xB1, 0xF, 0xF, true));
  x += __builtin_bit_cast(float, __builtin_amdgcn_update_dpp(0, __builtin_bit_cast(int, x), 0x4E, 0xF, 0xF, true));
  x += __builtin_bit_cast(float, __builtin_amdgcn_update_dpp(0, __builtin_bit_cast(int, x), 0x141, 0xF, 0xF, true));
  return x;
}
DI float red64(float x) {
  for (int o = 32; o > 0; o >>= 1) x += __shfl_xor(x, o);
  return x;
}
DI int crow(int reg, int h) { return (reg & 3) + 8 * (reg >> 2) + 4 * h; }
DI bf16x8 pack_acc(const f32x16& x, int s) {
  u32x4 p = {pk2(x[8 * s + 0], x[8 * s + 1]), pk2(x[8 * s + 2], x[8 * s + 3]), pk2(x[8 * s + 4], x[8 * s + 5]), pk2(x[8 * s + 6], x[8 * s + 7])};
  return __builtin_bit_cast(bf16x8, p);
}

__device__ void phase0(const Params& P, char* smem) {
  const int tid = tid_(), nb = gridDim.x, bid = blockIdx.x;
  if (bid == 0) for (int i = tid; i < 1024; i += NT) P.ctr[i] = 0u;
  { const int stride = nb * NT; int i = bid * NT + tid;
    for (; i + 3 * stride < TT * 128; i += 4 * stride) {
      float f[4][8];
#pragma unroll
      for (int u = 0; u < 4; ++u) { const int ii = i + u * stride, row = ii >> 7, c8 = (ii & 127) * 8;
        ld8f(row < TP ? P.x_prompt + (size_t)row * 1024 + c8 : P.x_sample + (size_t)(row - TP) * 1024 + c8, f[u]); }
#pragma unroll
      for (int u = 0; u < 4; ++u) { const int ii = i + u * stride, row = ii >> 7, c8 = (ii & 127) * 8; *(u32x4*)(P.xb + (size_t)row * 1024 + c8) = pack8(f[u]); }
    }
    for (; i < TT * 128; i += stride) { const int row = i >> 7, c8 = (i & 127) * 8; float f[8];
      ld8f(row < TP ? P.x_prompt + (size_t)row * 1024 + c8 : P.x_sample + (size_t)(row - TP) * 1024 + c8, f);
      *(u32x4*)(P.xb + (size_t)row * 1024 + c8) = pack8(f); } }
  for (int i = bid * NT + tid; i < 128 * 128; i += nb * NT) { u32x4 z = {0u, 0u, 0u, 0u}; *(u32x4*)(P.xb + (size_t)TT * 1024 + (size_t)i * 8) = z; }
  float* tile = (float*)smem;
  const int njobs = 16 * 148 + 3 * 256;
  const int kk0 = tid >> 4, nn = (tid & 15) * 4;
  f32x4 v0, v1;
  auto job_load = [&](int j) {
    const float* src; int ldsrc, k0, n0; bool isin;
    if (j < 16 * 148) { isin = true; src = P.w_in; ldsrc = 9360; k0 = (j & 15) * 64; n0 = (j >> 4) * 64; }
    else { int jj = j - 16 * 148; const int w = jj >> 8; jj &= 255; isin = false; ldsrc = 1024; src = w == 0 ? P.w_upg : (w == 1 ? P.w_upr : P.w_out); k0 = (jj & 15) * 64; n0 = (jj >> 4) * 64; }
    const int np = n0 + nn; int n = np;
    if (isin) n = np < 3088 ? np : (np < 3200 ? -1 : np - 112);
    v0 = (f32x4){0.f, 0.f, 0.f, 0.f}; v1 = v0;
    if (n >= 0) { v0 = *(const f32x4*)(src + (size_t)(k0 + kk0) * ldsrc + n); v1 = *(const f32x4*)(src + (size_t)(k0 + kk0 + 32) * ldsrc + n); }
  };
  if (bid < njobs) job_load(bid);
  for (int j = bid; j < njobs; j += nb) {
    bf16_t* dst; int k0, n0;
    if (j < 16 * 148) { dst = P.Wtin; k0 = (j & 15) * 64; n0 = (j >> 4) * 64; }
    else { int jj = j - 16 * 148; const int w = jj >> 8; jj &= 255; dst = w == 0 ? P.Wupg : (w == 1 ? P.Wupr : P.Wout); k0 = (jj & 15) * 64; n0 = (jj >> 4) * 64; }
    tile[kk0 * 65 + nn] = v0[0]; tile[kk0 * 65 + nn + 1] = v0[1]; tile[kk0 * 65 + nn + 2] = v0[2]; tile[kk0 * 65 + nn + 3] = v0[3];
    tile[(kk0 + 32) * 65 + nn] = v1[0]; tile[(kk0 + 32) * 65 + nn + 1] = v1[1]; tile[(kk0 + 32) * 65 + nn + 2] = v1[2]; tile[(kk0 + 32) * 65 + nn + 3] = v1[3];
    if (j + nb < njobs) job_load(j + nb);
    __syncthreads();
    { const int n2 = tid >> 3, ks = (tid & 7) * 8; float f[8];
#pragma unroll
      for (int e = 0; e < 8; ++e) f[e] = tile[(ks + e) * 65 + n2];
      *(u32x4*)(dst + (size_t)(n0 + n2) * 1024 + k0 + ks) = pack8(f); }
    __syncthreads();
  }
}

constexpr int ROWB = 144;
namespace g8 {
#define G8_LAS __attribute__((address_space(3)))
constexpr int BM = 256, BK = 64, HALF = 128, HTB = HALF * BK * 2, STAGE_BYTES = 8 * HTB, NXCD = 8, WGM = 8;
DI int lds_byte(int r, int c) { const int st = (r >> 4) * 2 + (c >> 5), rr = r & 15, cc = c & 31, ob = rr * 64 + cc * 2; return st * 1024 + (ob ^ (((ob >> 9) & 1) << 5)); }
DI void stage_rc(int b, int& R, int& C) { const int st = b / 1024, sb = b % 1024, swz = sb ^ (((sb >> 9) & 1) << 5); R = (st >> 1) * 16 + swz / 64; C = (st & 1) * 32 + (swz % 64) / 2; }
DI int perm32(int rho) { const int n = rho >> 4, i = rho & 15; return 8 * (i >> 2) + 4 * n + (i & 3); }
struct Unit { int pm, pn, sub; };
struct Job { const bf16_t* A0; const bf16_t* A1; const bf16_t* B0; const bf16_t* B1; int lda, K; };
struct Order {
  int nM, nN, nwg, G, c, nsub;
  DI void init(int nM_, int nN_, int G_, int c_, int nsub_) { nM = nM_; nN = nN_; nwg = nM * nN; G = G_; c = c_; nsub = nsub_; }
  DI bool next(int i, Unit& u) const {
    const int ti = nsub == 2 ? (i >> 1) : i; u.sub = nsub == 2 ? (i & 1) : 0;
    const long L = (long)ti * G + c; if (L >= nwg) return false;
    int wgid = (int)L; { const int q = nwg / NXCD, r = nwg % NXCD, xcd = wgid % NXCD, off = wgid / NXCD; wgid = (xcd < r ? xcd * (q + 1) : r * (q + 1) + (xcd - r) * q) + off; }
    const int nig = WGM * nN, gid = wgid / nig, fm = gid * WGM, gsz = (nM - fm) < WGM ? (nM - fm) : WGM;
    u.pm = fm + ((wgid % nig) % gsz); u.pn = (wgid % nig) / gsz; return true;
  }
};
template <class Epi>
DI void gemm_phase(G8_LAS unsigned char* lds, const Job g, const Order& S, Epi& E) {
  const int tid = tid_(), wid = __builtin_amdgcn_readfirstlane(tid >> 6), lane = tid & 63, wr = wid >> 2, wc = wid & 3, fr = lane & 15, fq = lane >> 4;
  const int K = g.K, nt = K / BK;
  unsigned voffA[2], voffB[2];
#pragma unroll
  for (int i = 0; i < 2; ++i) { int R, C; stage_rc(tid * 16 + i * 8192, R, C); const int Rb = (R & ~31) + perm32(R & 31);
    voffA[i] = (unsigned)(R * g.lda + C) * 2u; voffB[i] = (unsigned)(Rb * K + C) * 2u; }
  const size_t kstep = (size_t)(BK * 2);
  const size_t hstepA = (size_t)HALF * g.lda * 2, hstepB = (size_t)HALF * K * 2;
  const size_t tstepA = 2 * hstepA, tstepB = 2 * hstepB;
  const unsigned ldsw = (unsigned)wid * 1024u;
  const int aoff = lds_byte(wr * 64 + fr, fq * 8), boff = lds_byte(wc * 32 + fr, fq * 8);
#define G8_SA(b, h) (((b) * 2 + (h)) * HTB)
#define G8_SB(b, h) ((4 + (b) * 2 + (h)) * HTB)
#define G8_STAGE(bufoff, gbase, voff) do { _Pragma("unroll") for (int _i = 0; _i < 2; ++_i) \
    __builtin_amdgcn_global_load_lds((const unsigned*)((const char*)(gbase) + (voff)[_i]), (G8_LAS unsigned*)(lds + (bufoff) + ldsw + _i * 8192), 16, 0, 0); } while (0)
#define G8_LDA(dst, b, h) do { _Pragma("unroll") for (int m = 0; m < 4; ++m) _Pragma("unroll") for (int k = 0; k < 2; ++k) dst[m][k] = *(const G8_LAS bf16x8*)(lds + G8_SA(b, h) + aoff + m * 2048 + k * 1024); } while (0)
#define G8_LDB(dst, b, h) do { _Pragma("unroll") for (int n = 0; n < 2; ++n) _Pragma("unroll") for (int k = 0; k < 2; ++k) dst[n][k] = *(const G8_LAS bf16x8*)(lds + G8_SB(b, h) + boff + n * 2048 + k * 1024); } while (0)
#define G8_MMA(ai, bj, At, Bt) do { __builtin_amdgcn_s_setprio(1); _Pragma("unroll") for (int m = 0; m < 4; ++m) _Pragma("unroll") for (int n = 0; n < 2; ++n) _Pragma("unroll") for (int k = 0; k < 2; ++k) \
    acc[ai][bj][m][n] = __builtin_amdgcn_mfma_f32_16x16x32_bf16(Bt[n][k], At[m][k], acc[ai][bj][m][n], 0, 0, 0); __builtin_amdgcn_s_setprio(0); } while (0)
#define G8_WAIT_V(n) asm volatile("s_waitcnt vmcnt(" #n ")" ::: "memory")
#define G8_WAIT_L(n) asm volatile("s_waitcnt lgkmcnt(" #n ")" ::: "memory")
#define G8_BAR __builtin_amdgcn_s_barrier()
#define G8_SCHED __builtin_amdgcn_sched_barrier(0)
  Unit cur, nxt; int ui = 0;
  if (!S.next(0, cur)) return;
  f32x4 acc[2][2][4][2];
#pragma unroll
  for (int a = 0; a < 2; ++a)
#pragma unroll
    for (int b = 0; b < 2; ++b)
#pragma unroll
      for (int m = 0; m < 4; ++m)
#pragma unroll
        for (int n = 0; n < 2; ++n) acc[a][b][m][n] = (f32x4){0.f, 0.f, 0.f, 0.f};
  bf16x8 At[4][2], B0[2][2], B1[2][2];
  const char* cA = (const char*)(cur.sub ? g.A1 : g.A0) + (size_t)cur.pm * tstepA; const char* cB = (const char*)(cur.sub ? g.B1 : g.B0) + (size_t)cur.pn * tstepB;
  G8_STAGE(G8_SB(0, 0), cB, voffB); G8_STAGE(G8_SA(0, 0), cA, voffA); G8_STAGE(G8_SB(0, 1), cB + hstepB, voffB); G8_STAGE(G8_SA(0, 1), cA + hstepA, voffA);
  if (wr == 1) G8_BAR;
  G8_WAIT_V(4); G8_BAR;
  G8_STAGE(G8_SB(1, 0), cB + kstep, voffB); G8_STAGE(G8_SA(1, 0), cA + kstep, voffA); G8_STAGE(G8_SB(1, 1), cB + hstepB + kstep, voffB);
  G8_WAIT_V(6); G8_BAR;
  for (;;) {
    const bool has_next = S.next(ui + 1, nxt);
    const char* nA = has_next ? (const char*)(nxt.sub ? g.A1 : g.A0) + (size_t)nxt.pm * tstepA : cA;
    const char* nB = has_next ? (const char*)(nxt.sub ? g.B1 : g.B0) + (size_t)nxt.pn * tstepB : cB;
    for (int t = 0; t < nt; t += 2) {
      const bool last = (t == nt - 2);
      const char* a1 = cA + (size_t)(t + 1) * kstep;
      const char* a2 = last ? nA : cA + (size_t)(t + 2) * kstep; const char* b2 = last ? nB : cB + (size_t)(t + 2) * kstep;
      const char* a3 = a2 + kstep; const char* b3 = b2 + kstep;
      G8_LDB(B0, 0, 0); G8_SCHED; G8_LDA(At, 0, 0); G8_STAGE(G8_SA(1, 1), a1 + hstepA, voffA);
      G8_WAIT_L(8); G8_BAR; G8_WAIT_L(0); G8_MMA(0, 0, At, B0); G8_BAR; G8_SCHED;
      G8_LDB(B1, 0, 1); G8_STAGE(G8_SB(0, 0), b2, voffB);
      G8_BAR; G8_WAIT_L(0); G8_MMA(0, 1, At, B1); G8_BAR;
      G8_LDA(At, 0, 1); G8_STAGE(G8_SA(0, 0), a2, voffA);
      G8_BAR; G8_WAIT_L(0); G8_MMA(1, 0, At, B0); G8_BAR; G8_SCHED;
      G8_STAGE(G8_SB(0, 1), b2 + hstepB, voffB);
      G8_WAIT_V(6); G8_BAR; G8_MMA(1, 1, At, B1); G8_BAR;
      G8_LDB(B0, 1, 0); G8_SCHED; G8_LDA(At, 1, 0); G8_STAGE(G8_SA(0, 1), a2 + hstepA, voffA);
      G8_WAIT_L(8); G8_BAR; G8_WAIT_L(0); G8_MMA(0, 0, At, B0); G8_BAR; G8_SCHED;
      G8_LDB(B1, 1, 1); G8_STAGE(G8_SB(1, 0), b3, voffB);
      G8_BAR; G8_WAIT_L(0); G8_MMA(0, 1, At, B1); G8_BAR;
      G8_LDA(At, 1, 1); G8_STAGE(G8_SA(1, 0), a3, voffA);
      G8_BAR; G8_WAIT_L(0); G8_MMA(1, 0, At, B0); G8_BAR; G8_SCHED;
      G8_STAGE(G8_SB(1, 1), b3 + hstepB, voffB);
      G8_WAIT_V(6); G8_BAR; G8_MMA(1, 1, At, B1); G8_BAR;
    }
    const bool keep = E(acc, cur, wr, wc, fr, fq);
    if (!has_next) break;
    if (!keep) {
#pragma unroll
      for (int a = 0; a < 2; ++a)
#pragma unroll
        for (int b = 0; b < 2; ++b)
#pragma unroll
          for (int m = 0; m < 4; ++m)
#pragma unroll
            for (int n = 0; n < 2; ++n) acc[a][b][m][n] = (f32x4){0.f, 0.f, 0.f, 0.f};
    }
    cur = nxt; cA = nA; cB = nB; ++ui;
  }
  G8_WAIT_V(0);
  if (wr == 0) G8_BAR;
  G8_BAR;
#undef G8_SA
#undef G8_SB
#undef G8_STAGE
#undef G8_LDA
#undef G8_LDB
#undef G8_MMA
#undef G8_WAIT_V
#undef G8_WAIT_L
#undef G8_BAR
#undef G8_SCHED
}
}

struct Epi1 {
  const Params* P; int pn_off;
  DI bool operator()(f32x4 (&acc)[2][2][4][2], const g8::Unit& u0, int wr, int wc, int fr, int fq) const {
    const Params& Q = *P; g8::Unit u = u0; u.pn += pn_off;
#pragma unroll
    for (int ai = 0; ai < 2; ++ai)
#pragma unroll
      for (int m = 0; m < 4; ++m) {
        const int row = u.pm * 256 + ai * 128 + wr * 64 + m * 16 + fr;
#pragma unroll
        for (int bj = 0; bj < 2; ++bj) {
          const int col = u.pn * 256 + bj * 128 + wc * 32 + 8 * fq;
          const f32x4 v0 = acc[ai][bj][m][0], v1 = acc[ai][bj][m][1];
          if (col < GATE) {
            u32x4 o = {pk2(v0[0], v0[1]), pk2(v0[2], v0[3]), pk2(v1[0], v1[1]), pk2(v1[2], v1[3])};
            *(u32x4*)(Q.P + (size_t)row * LDP + col) = o;
            if (col >= RW && row < TT) {
              float* d = nullptr;
              if (row >= TP) d = Q.out + O_SHS + (size_t)(row - TP) * 4224 + (col - RW);
              else if ((row & 2047) == 2047) d = Q.out + O_SHP + (size_t)(row >> 11) * 4224 + (col - RW);
              if (d) { *(f32x4*)d = v0; *(f32x4*)(d + 4) = v1; }
            }
          } else if (row < TT) {
            u32x4 o = {pk2(sigm(v0[0]), sigm(v0[1])), pk2(sigm(v0[2]), sigm(v0[3])), pk2(sigm(v1[0]), sigm(v1[1])), pk2(sigm(v1[2]), sigm(v1[3]))};
            *(u32x4*)(Q.SG + (size_t)row * 2048 + (col - GATE)) = o;
          }
        }
      }
    return false;
  }
};
__device__ void phase1(const Params& P, char* smem) {
  g8::Job g; g.A0 = P.xb; g.A1 = P.xb; g.B0 = P.Wtin; g.B1 = P.Wtin; g.lda = 1024; g.K = 1024;
  g8::Order S; S.init(65, NTILE_N1 - 8, (int)gridDim.x, (int)blockIdx.x, 1);
  Epi1 E; E.P = &P; E.pn_off = 0;
  g8::gemm_phase((G8_LAS unsigned char*)smem, g, S, E);
}
__device__ void phase1_gates(const Params& P, char* smem, int nblk, int c) {
  g8::Job g; g.A0 = P.xb; g.A1 = P.xb; g.B0 = P.Wtin + (size_t)(NTILE_N1 - 8) * 256 * 1024; g.B1 = g.B0; g.lda = 1024; g.K = 1024;
  g8::Order S; S.init(65, 8, nblk, c, 1);
  Epi1 E; E.P = &P; E.pn_off = NTILE_N1 - 8;
  g8::gemm_phase((G8_LAS unsigned char*)smem, g, S, E);
}

constexpr int G_QT = 0, G_KT = 17408, G_KHT = 34816, G_VT = 53248, G_AM = 90112, G_ALR = 99328, G_BL = 103424, G_SEG = 103936, G_SSQ = 105984, G_B = 108032, G_EBL = 141824, G_NW = 142336;
__device__ void gla_prompt_unit(const Params& P, char* smem, int b, int hd, bool dry) {
  const int tid = tid_(), lane = tid & 63, wid = __builtin_amdgcn_readfirstlane(tid >> 6), h = lane >> 5, l31 = lane & 31;
  float* ALR = (float*)(smem + G_ALR); float* BL = (float*)(smem + G_BL); float* SEG = (float*)(smem + G_SEG); float* SSQ = (float*)(smem + G_SSQ);
  float* Bc = (float*)(smem + G_B);
  float* EBL = (float*)(smem + G_EBL);
  float* NW = (float*)(smem + G_NW);
  if (tid < 256) NW[tid] = P.gla_nw[tid];
  const int dk = tid & 127, seg = tid >> 7;
  const int li = tid & 63, lg = tid >> 6;
  const int i6 = tid >> 3, sg8 = tid & 7;
  float w2c[16];
#pragma unroll
  for (int j = 0; j < 16; ++j) w2c[j] = P.gla_w2[j * 512 + hd * 128 + dk];
  const float bias = P.gla_b[hd * 128 + dk];
  f32x16 S[4];
#pragma unroll
  for (int kb = 0; kb < 4; ++kb)
#pragma unroll
    for (int e = 0; e < 16; ++e) S[kb][e] = 0.f;
  const float qscale = 0.08838834764831845f;
  u32x4 rq[2], rk[2], rv[4], rga[4]; u32x2 ralr = {0u, 0u};
  u32x4 ost[4];
  auto flush_out = [&](int c) {
    if (dry) return;
    bf16_t* op = P.P + ((size_t)b * 2048 + c * 64 + i6) * LDP + GG + hd * 256 + 32 * sg8;
#pragma unroll
    for (int q4 = 0; q4 < 4; ++q4) *(u32x4*)(op + 8 * q4) = ost[q4];
  };
  auto issue_qkv = [&](int c) {
    const bf16_t* rowp = P.P + ((size_t)b * 2048 + c * 64 + li) * LDP;
#pragma unroll
    for (int it = 0; it < 2; ++it) { rq[it] = *(const u32x4*)(rowp + GQ + hd * 128 + 8 * (lg + 8 * it)); rk[it] = *(const u32x4*)(rowp + GK + hd * 128 + 8 * (lg + 8 * it)); }
#pragma unroll
    for (int it = 0; it < 4; ++it) rv[it] = *(const u32x4*)(rowp + GV + hd * 256 + 8 * (lg + 8 * it));
  };
  auto issue_alr = [&](int c) {
    if (tid < 256) ralr = *(const u32x2*)(P.P + ((size_t)b * 2048 + c * 64 + (tid >> 2)) * LDP + GA + (tid & 3) * 4);
  };
  auto issue_ga = [&](int c) {
    const bf16_t* gp = P.P + ((size_t)b * 2048 + c * 64 + i6) * LDP + GG + hd * 256 + 32 * sg8;
#pragma unroll
    for (int q4 = 0; q4 < 4; ++q4) rga[q4] = *(const u32x4*)(gp + 8 * q4);
  };
  issue_alr(0);

  for (int c = 0; c < 32; ++c) {
    const size_t rb = (size_t)b * 2048 + c * 64;
    issue_qkv(c);
    if (tid < 256) { f32x4 f = {bflo(ralr[0]), bfhi(ralr[0]), bflo(ralr[1]), bfhi(ralr[1])}; *(f32x4*)(ALR + (tid >> 2) * 16 + (tid & 3) * 4) = f; }
    __syncthreads();
    { float bc[16]; float run = 0.f;
#pragma unroll
      for (int ii = 0; ii < 16; ++ii) {
        const int i = 16 * seg + ii; float x = bias;
#pragma unroll
        for (int j4 = 0; j4 < 4; ++j4) { const f32x4 a = *(const f32x4*)(ALR + i * 16 + 4 * j4);
          x += a[0] * w2c[4 * j4] + a[1] * w2c[4 * j4 + 1] + a[2] * w2c[4 * j4 + 2] + a[3] * w2c[4 * j4 + 3]; }
        run += logsig(x) * 0.0625f; bc[ii] = run;
      }
      SEG[seg * 128 + dk] = run;
      __syncthreads();
      float off = 0.f, tot = 0.f;
#pragma unroll
      for (int s = 0; s < 4; ++s) { const float v = SEG[s * 128 + dk]; tot += v; if (s < seg) off += v; }
      if (seg == 0) { BL[dk] = tot; EBL[dk] = __expf(tot); }
#pragma unroll
      for (int ii = 0; ii < 16; ++ii) Bc[(16 * seg + ii) * 132 + dk] = bc[ii] + off; }
    __syncthreads();
#pragma unroll
    for (int it = 0; it < 2; ++it) {
      const int dk0 = 8 * (lg + 8 * it); float qf[8], kf[8], bb[8], tt[8], qt[8], kt[8];
      unpack8(rq[it], qf); unpack8(rk[it], kf); ld8f(Bc + li * 132 + dk0, bb); ld8f(EBL + dk0, tt);
#pragma unroll
      for (int e = 0; e < 8; ++e) { qt[e] = qf[e] * qscale * __expf(bb[e]); kt[e] = kf[e] * __expf(-bb[e]);
        *(bf16_t*)(smem + G_KHT + (dk0 + e) * ROWB + li * 2) = f2bf(kt[e] * tt[e]); }
      *(u32x4*)(smem + G_QT + li * 272 + dk0 * 2) = pack8(qt); *(u32x4*)(smem + G_KT + li * 272 + dk0 * 2) = pack8(kt);
      __builtin_amdgcn_sched_barrier(0);
    }
#pragma unroll
    for (int it = 0; it < 4; ++it) { const int dv0 = 8 * (lg + 8 * it);
#pragma unroll
      for (int e = 0; e < 4; ++e) { *(bf16_t*)(smem + G_VT + (dv0 + 2 * e) * ROWB + li * 2) = (bf16_t)(rv[it][e] & 0xffffu); *(bf16_t*)(smem + G_VT + (dv0 + 2 * e + 1) * ROWB + li * 2) = (bf16_t)(rv[it][e] >> 16); } }
    if (c > 0) flush_out(c - 1);
    __syncthreads();
    issue_ga(c);
    f32x16 o[2];
#pragma unroll
    for (int ib = 0; ib < 2; ++ib)
#pragma unroll
      for (int e = 0; e < 16; ++e) o[ib][e] = 0.f;
#pragma unroll
    for (int kb = 0; kb < 4; ++kb)
#pragma unroll
      for (int s = 0; s < 2; ++s) {
        const bf16x8 sp = pack_acc(S[kb], s);
#pragma unroll
        for (int ib = 0; ib < 2; ++ib) {
          const char* qp = smem + G_QT + (32 * ib + l31) * 272 + (32 * kb + 16 * s + 4 * h) * 2;
          const u32x2 q0 = *(const u32x2*)qp, q1 = *(const u32x2*)(qp + 16);
          u32x4 qq = {q0[0], q0[1], q1[0], q1[1]};
          o[ib] = MFMA(sp, __builtin_bit_cast(bf16x8, qq), o[ib]);
        }
      }
    if (wid < 4) {
      const int bi = wid >> 1, bj = wid & 1;
      f32x16 am;
#pragma unroll
      for (int e = 0; e < 16; ++e) am[e] = 0.f;
      if (wid != 1) {
#pragma unroll
        for (int ks = 0; ks < 8; ++ks) {
          const bf16x8 qf = *(const bf16x8*)(smem + G_QT + (32 * bi + l31) * 272 + ks * 32 + h * 16);
          const bf16x8 kf = *(const bf16x8*)(smem + G_KT + (32 * bj + l31) * 272 + ks * 32 + h * 16);
          am = MFMA(kf, qf, am);
        }
      }
      const int i = 32 * bi + l31;
#pragma unroll
      for (int g4 = 0; g4 < 4; ++g4) { float v[4];
#pragma unroll
        for (int e = 0; e < 4; ++e) { const int j = 32 * bj + 8 * g4 + 4 * h + e; v[e] = (j <= i) ? am[4 * g4 + e] : 0.f; }
        u32x2 ov = {pk2(v[0], v[1]), pk2(v[2], v[3])};
        *(u32x2*)(smem + G_AM + i * ROWB + (32 * bj + 8 * g4 + 4 * h) * 2) = ov; }
    }
    __syncthreads();
    { bf16x8 vf[4];
#pragma unroll
      for (int ks = 0; ks < 4; ++ks) vf[ks] = *(const bf16x8*)(smem + G_VT + (32 * wid + l31) * ROWB + ks * 32 + h * 16);
#pragma unroll
      for (int ib = 0; ib < 2; ++ib)
#pragma unroll
        for (int ks = 0; ks < 4; ++ks) { const bf16x8 af = *(const bf16x8*)(smem + G_AM + (32 * ib + l31) * ROWB + ks * 32 + h * 16);
          o[ib] = MFMA(vf[ks], af, o[ib]); }
#pragma unroll
      for (int kb = 0; kb < 4; ++kb) {
#pragma unroll
        for (int g4 = 0; g4 < 4; ++g4) { const f32x4 bl = *(const f32x4*)(EBL + 32 * kb + 8 * g4 + 4 * h);
#pragma unroll
          for (int e = 0; e < 4; ++e) S[kb][4 * g4 + e] *= bl[e]; }
#pragma unroll
        for (int ks = 0; ks < 4; ++ks) { const bf16x8 kf = *(const bf16x8*)(smem + G_KHT + (32 * kb + l31) * ROWB + ks * 32 + h * 16);
          S[kb] = MFMA(kf, vf[ks], S[kb]); }
      } }
#pragma unroll
    for (int ib = 0; ib < 2; ++ib) { float s = 0.f;
#pragma unroll
      for (int e = 0; e < 16; ++e) s += o[ib][e] * o[ib][e];
      s += __shfl_xor(s, 32);
      if (lane < 32) SSQ[wid * 64 + 32 * ib + lane] = s; }
    __syncthreads();
    if (c + 1 < 32) issue_alr(c + 1);
#pragma unroll
    for (int ib = 0; ib < 2; ++ib)
#pragma unroll
      for (int g4 = 0; g4 < 4; ++g4) { u32x2 ov = {pk2(o[ib][4 * g4], o[ib][4 * g4 + 1]), pk2(o[ib][4 * g4 + 2], o[ib][4 * g4 + 3])};
        *(u32x2*)(smem + (32 * ib + l31) * 528 + (32 * wid + 8 * g4 + 4 * h) * 2) = ov; }
    __syncthreads();
    { float ss = 0.f;
#pragma unroll
      for (int w = 0; w < 8; ++w) ss += SSQ[w * 64 + i6];
      const float rs = rsqrtf(ss * (1.f / 256.f) + 1e-5f);
#pragma unroll
      for (int q4 = 0; q4 < 4; ++q4) { const int dv0 = 32 * sg8 + 8 * q4;
        float ov[8], gv[8], nw[8];
        unpack8(*(const u32x4*)(smem + i6 * 528 + dv0 * 2), ov);
        unpack8(rga[q4], gv);
        ld8f(NW + dv0, nw);
#pragma unroll
        for (int e = 0; e < 8; ++e) ov[e] = ov[e] * rs * nw[e] * silu(gv[e]);
        ost[q4] = pack8(ov); }
    }
  }
  flush_out(31);
#pragma unroll
  for (int kb = 0; kb < 4; ++kb)
#pragma unroll
    for (int e = 0; e < 16; ++e)
      P.out[O_GLAP + ((size_t)(b * 4 + hd) * 128 + 32 * kb + crow(e, h)) * 256 + 32 * wid + l31] = S[kb][e];
  __syncthreads();
}

constexpr int PB_KAP = 0, PB_RHO = 4608, PB_ALPT = 9216, PB_BETT = 14336, PB_VT = 19456, PB_TT = 24576, PB_NB = 27136, PB_MA = 29696, PB_MB = 32256, PB_CT = 34816, PB_SIZE = 35328;
constexpr int X_PB = 0, X_Y = 70656, X_GB = 87040, X_W2T = 95232, X_A2T = 104448, X_LIN = 113664, X_ARG = 122880, X_C3 = 139264, X_SEG = 140288,
              X_CONST = 142336, X_TS = 145664;
constexpr int R40 = 80;
DI bf16x8 ld_perm(const char* p) { const u32x2 q0 = *(const u32x2*)p, q1 = *(const u32x2*)(p + 16); u32x4 q = {q0[0], q0[1], q1[0], q1[1]}; return __builtin_bit_cast(bf16x8, q); }
DI void unpack4(u32x2 v, float (&f)[4]) { f[0] = bflo(v[0]); f[1] = bfhi(v[0]); f[2] = bflo(v[1]); f[3] = bfhi(v[1]); }
DI u32x2 pack4(const float (&f)[4]) { u32x2 o = {pk2(f[0], f[1]), pk2(f[2], f[3])}; return o; }
DI void ld4f(const float* p, float (&f)[4]) { const f32x4 a = *(const f32x4*)p; f[0] = a[0]; f[1] = a[1]; f[2] = a[2]; f[3] = a[3]; }
DI float red16(float x) {
  x = red8(x);
  x += __builtin_bit_cast(float, __builtin_amdgcn_update_dpp(0, __builtin_bit_cast(int, x), 0x140, 0xF, 0xF, true));
  return x;
}
__device__ void rwkv_prompt_unit(const Params& P, char* smem, int b, int hd, bool dry) {
  const int tid = tid_(), lane = tid & 63, wid = __builtin_amdgcn_readfirstlane(tid >> 6), h = lane >> 5, l31 = lane & 31;
  const int t = tid >> 4, cq = tid & 15, c4 = cq * 4, hc = hd * 64 + c4;
  { const int j = tid >> 3; const int cc8 = (tid & 7) * 8; float f[8], g[8];
    ld8f(P.w2 + j * 1024 + hd * 64 + cc8, f); ld8f(P.a2 + j * 1024 + hd * 64 + cc8, g);
#pragma unroll
    for (int e = 0; e < 8; ++e) { *(bf16_t*)(smem + X_W2T + (cc8 + e) * ROWB + j * 2) = f2bf(f[e]); *(bf16_t*)(smem + X_A2T + (cc8 + e) * ROWB + j * 2) = f2bf(g[e]); } }
  f32x16 St[2];
#pragma unroll
  for (int kb = 0; kb < 2; ++kb)
#pragma unroll
    for (int e = 0; e < 16; ++e) St[kb][e] = 0.f;
  float* CONSTS = (float*)(smem + X_CONST);
  if (tid < 64) { const int c = hd * 64 + tid;
    CONSTS[tid] = P.mu[c]; CONSTS[64 + tid] = P.mu[1024 + c]; CONSTS[128 + tid] = P.mu[2048 + c]; CONSTS[192 + tid] = P.mu[3072 + c];
    CONSTS[256 + tid] = P.w0[c]; CONSTS[320 + tid] = P.a0[c]; CONSTS[384 + tid] = P.k_k[c]; CONSTS[448 + tid] = P.k_a[c]; CONSTS[512 + tid] = P.r_k[c];
    CONSTS[576 + tid] = P.lnx_w[c]; CONSTS[640 + tid] = P.lnx_b[c]; CONSTS[704 + tid] = P.mu[4096 + tid]; CONSTS[768 + tid] = P.mu[4160 + tid]; }
  __syncthreads();

  for (int it = -1; it < 65; ++it) {
    const int kp = it + 1;
    const bool do_pre = kp < 64, do_post = it >= 1, do_cons = it >= 0 && it < 64;
    u32x2 Lw, La, Lwq, Laq, Lr, Lk, Lv, Lg, Lrq, Lkq, Lvq, Lgq;
    const size_t r = (size_t)b * 2048 + (size_t)(do_pre ? kp : 0) * 32 + t;
    const bool first = (kp == 0 && t == 0);
    const int p = kp & 1;
    char* PB = smem + X_PB + p * PB_SIZE;
    float* WARG = (float*)(smem + X_ARG); float* LW = WARG + 2048;
    float* C3 = (float*)(smem + X_C3) + p * 128; float* SEGT = (float*)(smem + X_SEG); float* CT = (float*)(PB + PB_CT);
    if (do_pre) {
      const bf16_t* pr = P.P + r * LDP; const bf16_t* pq = first ? P.P + (size_t)TT * LDP : pr - LDP;
      Lw = *(const u32x2*)(pr + RWL + c4); La = *(const u32x2*)(pr + RAL + c4); Lwq = *(const u32x2*)(pq + RWL + c4); Laq = *(const u32x2*)(pq + RAL + c4);
      Lr = *(const u32x2*)(pr + RR + hc); Lk = *(const u32x2*)(pr + RK + hc); Lv = *(const u32x2*)(pr + RV + hc); Lg = *(const u32x2*)(pr + RG + hc);
      Lrq = *(const u32x2*)(pq + RR + hc); Lkq = *(const u32x2*)(pq + RK + hc); Lvq = *(const u32x2*)(pq + RV + hc); Lgq = *(const u32x2*)(pq + RG + hc);
    }
    u32x2 post_val = {0u, 0u};
    if (do_post) {
      const int k = it - 1, pp = k & 1;
      const float* Y = (const float*)(smem + X_Y) + pp * 2048; const char* VT = smem + X_PB + pp * PB_SIZE + PB_VT;
      float y[4]; ld4f(Y + t * 64 + c4, y);
      const float mean = red16(y[0] + y[1] + y[2] + y[3]) * (1.f / 64.f); float q = 0.f;
#pragma unroll
      for (int e = 0; e < 4; ++e) { y[e] -= mean; q += y[e] * y[e]; }
      const float rs = rsqrtf(red16(q) * (1.f / 64.f) + 64e-5f);
      const float c3 = ((const float*)(smem + X_C3))[pp * 128 + t * 4 + 2]; float gg[4], lnw[4], lnb[4];
      ld4f(CONSTS + 576 + c4, lnw); ld4f(CONSTS + 640 + c4, lnb);
      unpack4(*(const u32x2*)(smem + X_GB + pp * 4096 + t * 128 + c4 * 2), gg);
#pragma unroll
      for (int e = 0; e < 4; ++e) { const float vv = bf2f(*(const bf16_t*)(VT + (c4 + e) * R40 + t * 2)); y[e] = (y[e] * rs * lnw[e] + lnb[e] + c3 * vv) * silu(gg[e]); }
      post_val = pack4(y);
    }
    float rr[4], kk[4], kka[4], km[4], lw[4], lc[4];
    if (do_pre) {
      { float pw[4], pa[4], qw[4], qa[4], mw[4], ma[4];
        unpack4(Lw, pw); unpack4(La, pa); unpack4(Lwq, qw); unpack4(Laq, qa);
        ld4f(CONSTS + 704 + c4, mw); ld4f(CONSTS + 768 + c4, ma);
#pragma unroll
        for (int e = 0; e < 4; ++e) {
          pw[e] = tanh_(pw[e] + (qw[e] - pw[e]) * mw[e]); pa[e] = pa[e] + (qa[e] - pa[e]) * ma[e]; }
        *(u32x2*)(smem + X_LIN + t * ROWB + c4 * 2) = pack4(pw); *(u32x2*)(smem + X_LIN + 4608 + t * ROWB + c4 * 2) = pack4(pa); }
    }
    __syncthreads();
    if (do_pre && wid < 4) {
      const int mm = wid >> 1, ni = wid & 1;
      f32x16 d;
#pragma unroll
      for (int e = 0; e < 16; ++e) d[e] = 0.f;
#pragma unroll
      for (int ks = 0; ks < 4; ++ks) {
        const bf16x8 af = *(const bf16x8*)(smem + X_LIN + mm * 4608 + l31 * ROWB + ks * 32 + h * 16);
        const bf16x8 bf = *(const bf16x8*)(smem + (mm ? X_A2T : X_W2T) + (32 * ni + l31) * ROWB + ks * 32 + h * 16);
        d = MFMA(af, bf, d);
      }
      float* dst = WARG + mm * 2048;
#pragma unroll
      for (int e = 0; e < 16; ++e) dst[crow(e, h) * 64 + 32 * ni + l31] = d[e];
    }
    __syncthreads();
    if (do_pre) {
      float pr[4], pk[4], pv[4], pg[4], qr[4], qk[4], qv[4], qg[4];
      unpack4(Lr, pr); unpack4(Lk, pk); unpack4(Lv, pv); unpack4(Lg, pg); unpack4(Lrq, qr); unpack4(Lkq, qk); unpack4(Lvq, qv); unpack4(Lgq, qg);
      float mur[4], muk[4], muv[4], mug[4], w0v[4], a0v[4], kkw[4], kaw[4], rkw[4];
      ld4f(CONSTS + c4, mur); ld4f(CONSTS + 64 + c4, muk); ld4f(CONSTS + 128 + c4, muv); ld4f(CONSTS + 192 + c4, mug);
      ld4f(CONSTS + 256 + c4, w0v); ld4f(CONSTS + 320 + c4, a0v); ld4f(CONSTS + 384 + c4, kkw); ld4f(CONSTS + 448 + c4, kaw); ld4f(CONSTS + 512 + c4, rkw);
      float ssq = 0.f, s3 = 0.f; float gg[4];
#pragma unroll
      for (int e = 0; e < 4; ++e) {
        rr[e] = pr[e] + (qr[e] - pr[e]) * mur[e];
        const float kb = pk[e] + (qk[e] - pk[e]) * muk[e];
        const float vv = pv[e] + (qv[e] - pv[e]) * muv[e];
        gg[e] = pg[e] + (qg[e] - pg[e]) * mug[e];
        const float wa = WARG[t * 64 + c4 + e] + w0v[e];
        lw[e] = -0.606531f * sigm(wa);
        const float a = sigm(LW[t * 64 + c4 + e] + a0v[e]);
        kk[e] = kb * kkw[e]; ssq += kk[e] * kk[e];
        km[e] = kb * (1.f + (a - 1.f) * kaw[e]);
        kka[e] = a;
        s3 += rr[e] * km[e] * rkw[e];
        *(bf16_t*)(PB + PB_VT + (c4 + e) * R40 + t * 2) = f2bf(vv);
      }
      ssq = red16(ssq);
      const float inv = __builtin_amdgcn_rcpf(fmaxf(sqrtf(ssq), 1e-12f));
#pragma unroll
      for (int e = 0; e < 4; ++e) { kk[e] *= inv; kka[e] *= kk[e]; }
      s3 = red16(s3);
      if (cq == 0) C3[t * 4 + 2] = s3;
      {
        const int trow = (tid >> 4) & 3;
#pragma unroll
        for (int e = 0; e < 4; ++e) { float x = lw[e]; float y = __shfl_up(x, 16); if (trow >= 1) x += y; y = __shfl_up(x, 32); if (trow >= 2) x += y; lc[e] = x; }
        if (trow == 3) { f32x4 tv = {lc[0], lc[1], lc[2], lc[3]}; *(f32x4*)(SEGT + (tid >> 6) * 64 + c4) = tv; } }
      *(u32x2*)(smem + X_GB + p * 4096 + t * 128 + c4 * 2) = pack4(gg);
    }
    __syncthreads();
    if (do_pre) {
      float ka[4], ro[4], al[4], be[4];
      f32x4 cumv = {lc[0], lc[1], lc[2], lc[3]};
      for (int s2_ = 0; s2_ < (t >> 2); ++s2_) cumv += *(const f32x4*)(SEGT + s2_ * 64 + c4);
      if (t == 31) *(f32x4*)(CT + c4) = cumv;
#pragma unroll
      for (int e = 0; e < 4; ++e) {
        const float cum = cumv[e], cprev = cum - lw[e];
        const float Ct = __expf(cum), Cp = __expf(cprev), iC = __expf(-cum);
        ka[e] = -kk[e] * Cp; ro[e] = rr[e] * Ct; al[e] = kka[e] * iC; be[e] = km[e] * iC;
        *(bf16_t*)(PB + PB_ALPT + (c4 + e) * R40 + t * 2) = f2bf(al[e]); *(bf16_t*)(PB + PB_BETT + (c4 + e) * R40 + t * 2) = f2bf(be[e]);
      }
      *(u32x2*)(PB + PB_KAP + t * ROWB + c4 * 2) = pack4(ka); *(u32x2*)(PB + PB_RHO + t * ROWB + c4 * 2) = pack4(ro);
      *(u32x2*)(smem + X_LIN + t * ROWB + c4 * 2) = pack4(al); *(u32x2*)(smem + X_LIN + 4608 + t * ROWB + c4 * 2) = pack4(be);
    }
    __syncthreads();
    if (do_post && !dry) *(u32x2*)(P.P + ((size_t)b * 2048 + (size_t)(it - 1) * 32 + t) * LDP + RG + hc) = post_val;
    if (do_pre && wid >= 4) {
      const int hw = wid - 4;
      const char* xa = PB + ((hw & 2) ? PB_RHO : PB_KAP); const char* ya = smem + X_LIN + ((hw & 1) ? 4608 : 0);
      f32x16 d;
#pragma unroll
      for (int e = 0; e < 16; ++e) d[e] = 0.f;
#pragma unroll
      for (int ks = 0; ks < 4; ++ks) {
        const bf16x8 yf = *(const bf16x8*)(ya + l31 * ROWB + ks * 32 + h * 16);
        const bf16x8 xf = *(const bf16x8*)(xa + l31 * ROWB + ks * 32 + h * 16);
        d = MFMA(yf, xf, d);
      }
      const bool incl = (hw & 2) != 0;
      int lt = l31; asm volatile("" : "+v"(lt));
#pragma unroll
      for (int e = 0; e < 16; ++e) { const int j = crow(e, h); d[e] = (incl ? (j <= lt) : (j < lt)) ? d[e] : 0.f; }
      if (hw != 0) {
        char* dst = PB + (hw == 1 ? PB_NB : (hw == 2 ? PB_MA : PB_MB));
#pragma unroll
        for (int g4 = 0; g4 < 4; ++g4) { u32x2 ov = {pk2(d[4 * g4], d[4 * g4 + 1]), pk2(d[4 * g4 + 2], d[4 * g4 + 3])};
          *(u32x2*)(dst + lt * R40 + (8 * g4 + 4 * h) * 2) = ov; }
      } else {
        char* Qrow = smem + X_TS;
        __builtin_amdgcn_s_setprio(3);
        f32x16 pa = d;
#pragma unroll
        for (int e = 0; e < 16; ++e) if (crow(e, h) == lt) pa[e] += 1.f;
#pragma unroll
        for (int e = 0; e < 16; ++e) *(bf16_t*)(Qrow + crow(e, h) * R40 + lt * 2) = f2bf(d[e]);
#pragma unroll 1
        for (int i = 0; i < 4; ++i) {
          asm volatile("s_waitcnt lgkmcnt(0)" ::: "memory");
          f32x16 qn;
#pragma unroll
          for (int e = 0; e < 16; ++e) qn[e] = 0.f;
          const bf16x8 qa0 = ld_perm(Qrow + lt * R40 + (4 * h) * 2), qa1 = ld_perm(Qrow + lt * R40 + (16 + 4 * h) * 2);
          qn = MFMA(qa0, pack_acc(d, 0), qn); qn = MFMA(qa1, pack_acc(d, 1), qn);
          d = qn;
#pragma unroll
          for (int e = 0; e < 16; ++e) *(bf16_t*)(Qrow + crow(e, h) * R40 + lt * 2) = f2bf(d[e]);
          asm volatile("s_waitcnt lgkmcnt(0)" ::: "memory");
          const bf16x8 qb0 = ld_perm(Qrow + lt * R40 + (4 * h) * 2), qb1 = ld_perm(Qrow + lt * R40 + (16 + 4 * h) * 2);
          const bf16x8 pp0 = pack_acc(pa, 0), pp1 = pack_acc(pa, 1);
          pa = MFMA(qb0, pp0, pa); pa = MFMA(qb1, pp1, pa);
        }
#pragma unroll
        for (int g4 = 0; g4 < 4; ++g4) { u32x2 ov = {pk2(pa[4 * g4], pa[4 * g4 + 1]), pk2(pa[4 * g4 + 2], pa[4 * g4 + 3])};
          *(u32x2*)(PB + PB_TT + lt * R40 + (8 * g4 + 4 * h) * 2) = ov; }
        __builtin_amdgcn_s_setprio(0);
      }
    } else if (do_cons && wid < 2) {
      const int pc = it & 1; const char* PC = smem + X_PB + pc * PB_SIZE; const int vrow = 32 * wid + l31;
      bf16x8 sp[2][2];
#pragma unroll
      for (int kb = 0; kb < 2; ++kb)
#pragma unroll
        for (int s = 0; s < 2; ++s) sp[kb][s] = pack_acc(St[kb], s);
      bf16x8 vf[2];
#pragma unroll
      for (int s = 0; s < 2; ++s) vf[s] = *(const bf16x8*)(PC + PB_VT + vrow * R40 + (16 * s + 8 * h) * 2);
      f32x16 X, Y;
#pragma unroll
      for (int e = 0; e < 16; ++e) { X[e] = 0.f; Y[e] = 0.f; }
#pragma unroll
      for (int kb = 0; kb < 2; ++kb)
#pragma unroll
        for (int s = 0; s < 2; ++s) {
          X = MFMA(ld_perm(PC + PB_KAP + l31 * ROWB + (32 * kb + 16 * s + 4 * h) * 2), sp[kb][s], X);
          Y = MFMA(ld_perm(PC + PB_RHO + l31 * ROWB + (32 * kb + 16 * s + 4 * h) * 2), sp[kb][s], Y);
        }
#pragma unroll
      for (int s = 0; s < 2; ++s) {
        X = MFMA(*(const bf16x8*)(PC + PB_NB + l31 * R40 + (16 * s + 8 * h) * 2), vf[s], X);
        Y = MFMA(*(const bf16x8*)(PC + PB_MB + l31 * R40 + (16 * s + 8 * h) * 2), vf[s], Y);
      }
      f32x16 U;
#pragma unroll
      for (int e = 0; e < 16; ++e) U[e] = 0.f;
#pragma unroll
      for (int s = 0; s < 2; ++s) U = MFMA(ld_perm(PC + PB_TT + l31 * R40 + (16 * s + 4 * h) * 2), pack_acc(X, s), U);
      bf16x8 up[2];
#pragma unroll
      for (int s = 0; s < 2; ++s) up[s] = pack_acc(U, s);
#pragma unroll
      for (int s = 0; s < 2; ++s) Y = MFMA(ld_perm(PC + PB_MA + l31 * R40 + (16 * s + 4 * h) * 2), up[s], Y);
      { float* Yo = (float*)(smem + X_Y) + pc * 2048;
#pragma unroll
        for (int e = 0; e < 16; ++e) Yo[crow(e, h) * 64 + vrow] = Y[e]; }
      const float* CTc = (const float*)(PC + PB_CT);
#pragma unroll
      for (int kb = 0; kb < 2; ++kb) {
#pragma unroll
        for (int s = 0; s < 2; ++s) {
          St[kb] = MFMA(ld_perm(PC + PB_ALPT + (32 * kb + l31) * R40 + (16 * s + 4 * h) * 2), up[s], St[kb]);
          St[kb] = MFMA(*(const bf16x8*)(PC + PB_BETT + (32 * kb + l31) * R40 + (16 * s + 8 * h) * 2), vf[s], St[kb]);
        }
#pragma unroll
        for (int g4 = 0; g4 < 4; ++g4) { const f32x4 ct = *(const f32x4*)(CTc + 32 * kb + 8 * g4 + 4 * h);
#pragma unroll
          for (int e = 0; e < 4; ++e) St[kb][4 * g4 + e] *= __expf(ct[e]); }
      }
    }
    __syncthreads();
  }
  if (wid < 2) {
#pragma unroll
    for (int kb = 0; kb < 2; ++kb)
#pragma unroll
      for (int g4 = 0; g4 < 4; ++g4) { f32x4 o = {St[kb][4 * g4], St[kb][4 * g4 + 1], St[kb][4 * g4 + 2], St[kb][4 * g4 + 3]};
        *(f32x4*)(P.out + O_RWKVP + ((size_t)(b * 16 + hd) * 64 + 32 * wid + l31) * 64 + 32 * kb + 8 * g4 + 4 * h) = o; }
  }
  __syncthreads();
}

__device__ void gla_sample_unit(const Params& P, char* smem, int sb, int hd, bool dry) {
  const int tid = tid_();
  float* AD = (float*)smem; float* Qs = AD + 128; float* Ks = Qs + 128; float* Vs = Ks + 128; float* OP = Vs + 256; float* RED = OP + 2048;
  const size_t r = (size_t)TP + sb;
  if (tid < 128) { const int dk = tid; float x = P.gla_b[hd * 128 + dk];
#pragma unroll
    for (int j = 0; j < 16; ++j) x += bf2f(P.P[r * LDP + GA + j]) * P.gla_w2[j * 512 + hd * 128 + dk];
    AD[dk] = __expf(logsig(x) * 0.0625f);
    Qs[dk] = bf2f(P.P[r * LDP + GQ + hd * 128 + dk]) * 0.08838834764831845f; Ks[dk] = bf2f(P.P[r * LDP + GK + hd * 128 + dk]); }
  else if (tid < 384) { const int dv = tid - 128; Vs[dv] = bf2f(P.P[r * LDP + GV + hd * 256 + dv]); }
  __syncthreads();
  { const int dv4 = (tid & 63) * 4, ds = tid >> 6; f32x4 oacc = {0.f, 0.f, 0.f, 0.f}; const f32x4 v4 = *(const f32x4*)(Vs + dv4);
    const size_t base = ((size_t)(sb * 4 + hd) * 128) * 256;
    f32x4 sin[16];
#pragma unroll
    for (int e = 0; e < 16; ++e) sin[e] = *(const f32x4*)(P.state_gla + base + (size_t)(16 * ds + e) * 256 + dv4);
#pragma unroll
    for (int e = 0; e < 16; ++e) { const int dk = 16 * ds + e;
      const f32x4 s4 = sin[e];
      const f32x4 sn = s4 * AD[dk] + v4 * Ks[dk];
      *(f32x4*)(P.out + O_GLAS + base + (size_t)dk * 256 + dv4) = sn;
      oacc += sn * Qs[dk]; }
    *(f32x4*)(OP + ds * 256 + dv4) = oacc; }
  __syncthreads();
  float ov = 0.f;
  if (tid < 256) { for (int s = 0; s < 8; ++s) ov += OP[s * 256 + tid]; const float q = red64(ov * ov); if ((tid & 63) == 0) RED[tid >> 6] = q; }
  __syncthreads();
  if (tid < 256) { const float rs = rsqrtf((RED[0] + RED[1] + RED[2] + RED[3]) * (1.f / 256.f) + 1e-5f);
    bf16_t* gp = P.P + r * LDP + GG + hd * 256 + tid;
    const bf16_t res = f2bf(ov * rs * P.gla_nw[tid] * silu(bf2f(*gp))); if (!dry) *gp = res; }
  __syncthreads();
}

__device__ void rwkv_sample_unit(const Params& P, char* smem, int sb, int half, bool dry) {
  const int tid = tid_(), lane = tid & 63, wid = tid >> 6;
  float* LWv = (float*)smem; float* LAv = LWv + 64; float* KK = LAv + 64; float* WW = KK + 512; float* KA = WW + 512; float* KM = KA + 512;
  float* RRv = KM + 512; float* VVv = RRv + 512; float* GBv = VVv + 512; float* Yv = GBv + 512; float* BON = Yv + 512;
  const size_t r = (size_t)TP + sb; const float* sh = P.state_shift + (size_t)sb * 4224;
  if (tid < 64) { const int j = tid;
    const float pw = bf2f(P.P[r * LDP + RWL + j]), pa = bf2f(P.P[r * LDP + RAL + j]);
    LWv[j] = tanh_(pw + (sh[4096 + j] - pw) * P.mu[4096 + j]); LAv[j] = pa + (sh[4160 + j] - pa) * P.mu[4160 + j]; }
  __syncthreads();
  { const int c = half * 512 + tid;
    float wa = P.w0[c], aa = P.a0[c];
#pragma unroll 32
    for (int j = 0; j < 64; ++j) { wa += LWv[j] * P.w2[j * 1024 + c]; aa += LAv[j] * P.a2[j * 1024 + c]; }
    const float pr = bf2f(P.P[r * LDP + RR + c]), pk = bf2f(P.P[r * LDP + RK + c]), pv = bf2f(P.P[r * LDP + RV + c]), pg = bf2f(P.P[r * LDP + RG + c]);
    const float rr = pr + (sh[c] - pr) * P.mu[c], kb = pk + (sh[1024 + c] - pk) * P.mu[1024 + c];
    const float vv = pv + (sh[2048 + c] - pv) * P.mu[2048 + c], gg = pg + (sh[3072 + c] - pg) * P.mu[3072 + c];
    const float w = __expf(-0.606531f * sigm(wa)), a = sigm(aa);
    float kk = kb * P.k_k[c]; const float nrm = sqrtf(red64(kk * kk)); kk = kk / fmaxf(nrm, 1e-12f);
    const float km = kb * (1.f + (a - 1.f) * P.k_a[c]);
    const float bon = red64(rr * km * P.r_k[c]);
    KK[tid] = -kk; WW[tid] = w; KA[tid] = kk * a; KM[tid] = km; RRv[tid] = rr; VVv[tid] = vv; GBv[tid] = gg; if (lane == 0) BON[wid] = bon; }
  __syncthreads();
  { const int row = tid >> 3, c8 = (tid & 7) * 8;
    float sall[8][8];
#pragma unroll
    for (int hh = 0; hh < 8; ++hh) ld8f(P.state_rwkv + ((size_t)(sb * 16 + half * 8 + hh) * 64 + row) * 64 + c8, sall[hh]);
#pragma unroll
    for (int hh = 0; hh < 8; ++hh) {
      const size_t base = ((size_t)(sb * 16 + half * 8 + hh) * 64 + row) * 64 + c8;
      float s[8]; float d = 0.f;
#pragma unroll
      for (int e = 0; e < 8; ++e) s[e] = sall[hh][e];
#pragma unroll
      for (int e = 0; e < 8; ++e) d += s[e] * KK[hh * 64 + c8 + e];
      const float sa = red8(d); const float vv = VVv[hh * 64 + row]; float y = 0.f;
#pragma unroll
      for (int e = 0; e < 8; ++e) { s[e] = s[e] * WW[hh * 64 + c8 + e] + sa * KA[hh * 64 + c8 + e] + vv * KM[hh * 64 + c8 + e]; y += s[e] * RRv[hh * 64 + c8 + e]; }
      f32x4 o0 = {s[0], s[1], s[2], s[3]}, o1 = {s[4], s[5], s[6], s[7]};
      *(f32x4*)(P.out + O_RWKVS + base) = o0; *(f32x4*)(P.out + O_RWKVS + base + 4) = o1;
      y = red8(y); if ((tid & 7) == 0) Yv[hh * 64 + row] = y;
    } }
  __syncthreads();
  { const int c = half * 512 + tid; const float y = Yv[tid]; const float mean = red64(y) * (1.f / 64.f); const float dd = y - mean;
    const float var = red64(dd * dd) * (1.f / 64.f);
    const float o = (dd * rsqrtf(var + 64e-5f) * P.lnx_w[c] + P.lnx_b[c] + BON[wid] * VVv[tid]) * silu(GBv[tid]);
    if (!dry) P.P[r * LDP + RG + c] = f2bf(o); }
  __syncthreads();
}

DI void blk_publish(unsigned* cnt) {
  asm volatile("s_waitcnt vmcnt(0)" ::: "memory");
  __syncthreads();
  if (threadIdx.x == 0) { __builtin_amdgcn_fence(__ATOMIC_RELEASE, "agent"); asm volatile("s_waitcnt vmcnt(0)" ::: "memory");
    __hip_atomic_fetch_add(cnt, 1u, __ATOMIC_RELAXED, __HIP_MEMORY_SCOPE_AGENT); }
}
DI void blk_wait(unsigned* cnt, unsigned target) {
  if (threadIdx.x == 0) { while (__hip_atomic_load(cnt, __ATOMIC_RELAXED, __HIP_MEMORY_SCOPE_AGENT) < target) __builtin_amdgcn_s_sleep(2);
    __builtin_amdgcn_fence(__ATOMIC_ACQUIRE, "agent"); asm volatile("s_waitcnt vmcnt(0)" ::: "memory"); }
  __syncthreads();
}
constexpr int C_PA = 384, C_SA = 448, C_PB = 512, C_SB = 576, C_BD = 640, C_QO = 704;
__device__ void phase2(const Params& P, char* smem, int roles, bool dry) {
  const int bid = blockIdx.x;
  if (bid < 128) { if (roles & 1) rwkv_prompt_unit(P, smem, bid >> 4, bid & 15, dry); if (!dry) blk_publish(P.ctr + C_BD + (bid >> 4)); }
  else if (bid < 160) { if (roles & 2) gla_prompt_unit(P, smem, (bid - 128) >> 2, (bid - 128) & 3, dry); if (!dry) blk_publish(P.ctr + C_BD + ((bid - 128) >> 2)); }
  const int tid = tid_();
  if (!dry) {
    const unsigned ngate = gridDim.x - 160;
    if (bid >= 160) {
      phase1_gates(P, smem, (int)ngate, bid - 160);
      asm volatile("s_waitcnt vmcnt(0)" ::: "memory");
      __syncthreads();
      if (tid == 0) { __builtin_amdgcn_fence(__ATOMIC_RELEASE, "agent"); __hip_atomic_fetch_add(P.ctr + 192, 1u, __ATOMIC_RELAXED, __HIP_MEMORY_SCOPE_AGENT); }
    }
    if (tid == 0) { while (__hip_atomic_load(P.ctr + 192, __ATOMIC_RELAXED, __HIP_MEMORY_SCOPE_AGENT) < ngate) __builtin_amdgcn_s_sleep(8); __builtin_amdgcn_fence(__ATOMIC_ACQUIRE, "agent"); }
    __syncthreads();
  }
  if (!(roles & 4)) return;
  unsigned* ctr = dry ? P.ctr + 128 : P.ctr;
  int* slot = (int*)(smem + SMEM_BYTES - 16);
  for (;;) {
    if (tid == 0) *slot = (int)atomicAdd(ctr, 1u);
    __syncthreads();
    const int u = *slot;
    __syncthreads();
    if (u >= 512 + 256) break;
    if (u < 512) gla_sample_unit(P, smem, u >> 2, u & 3, dry);
    else rwkv_sample_unit(P, smem, (u - 512) >> 1, (u - 512) & 1, dry);
  }
  if (!dry) blk_publish(P.ctr + C_QO);
}

DI float mini_gemm(const bf16_t* A, int lda, const bf16_t* Bt, int K, int r0, int c0, float* red) {
  const int tid = tid_(), lane = tid & 63, wid = tid >> 6, fr = lane & 15, fq = lane >> 4;
  f32x4 acc0 = {0.f, 0.f, 0.f, 0.f}, acc1 = {0.f, 0.f, 0.f, 0.f};
  const int kb = wid * 128;
  bf16x8 a0[4], a1[4], bb[4];
#pragma unroll
  for (int k = 0; k < 4; ++k) {
    a0[k] = *(const bf16x8*)(A + (size_t)(r0 + fr) * lda + kb + k * 32 + fq * 8); a1[k] = *(const bf16x8*)(A + (size_t)(r0 + 16 + fr) * lda + kb + k * 32 + fq * 8);
    bb[k] = *(const bf16x8*)(Bt + (size_t)(c0 + fr) * K + kb + k * 32 + fq * 8); }
#pragma unroll
  for (int k = 0; k < 4; ++k) {
    acc0 = __builtin_amdgcn_mfma_f32_16x16x32_bf16(a0[k], bb[k], acc0, 0, 0, 0);
    acc1 = __builtin_amdgcn_mfma_f32_16x16x32_bf16(a1[k], bb[k], acc1, 0, 0, 0);
  }
  __syncthreads();
#pragma unroll
  for (int j = 0; j < 4; ++j) { red[wid * 512 + (4 * fq + j) * 16 + fr] = acc0[j]; red[wid * 512 + (16 + 4 * fq + j) * 16 + fr] = acc1[j]; }
  __syncthreads();
  float v = 0.f;
#pragma unroll
  for (int w = 0; w < 8; ++w) v += red[w * 512 + tid];
  return v;
}

struct Epi3a {
  const Params* P;
  DI bool operator()(f32x4 (&acc)[2][2][4][2], const g8::Unit& u, int wr, int wc, int fr, int fq) const {
    const Params& Q = *P;
#pragma unroll
    for (int ai = 0; ai < 2; ++ai) {
      u32x4 gbv[4][2];
#pragma unroll
      for (int m = 0; m < 4; ++m)
#pragma unroll
        for (int bj = 0; bj < 2; ++bj) {
          const int row = u.pm * 256 + ai * 128 + wr * 64 + m * 16 + fr, col = u.pn * 256 + bj * 128 + wc * 32 + 8 * fq;
          gbv[m][bj] = *(const u32x4*)(Q.SG + (size_t)row * 2048 + 1024 + col); }
#pragma unroll
      for (int m = 0; m < 4; ++m) {
        const int row = u.pm * 256 + ai * 128 + wr * 64 + m * 16 + fr;
#pragma unroll
        for (int bj = 0; bj < 2; ++bj) {
          const int col = u.pn * 256 + bj * 128 + wc * 32 + 8 * fq;
          float gb[8]; unpack8(gbv[m][bj], gb);
          if (u.sub == 0) {
            float ga[8]; unpack8(*(const u32x4*)(Q.SG + (size_t)row * 2048 + col), ga);
#pragma unroll
            for (int j = 0; j < 4; ++j) { acc[ai][bj][m][0][j] *= ga[j] * __builtin_amdgcn_rcpf(gb[j]); acc[ai][bj][m][1][j] *= ga[4 + j] * __builtin_amdgcn_rcpf(gb[4 + j]); }
          } else {
            const f32x4 v0 = acc[ai][bj][m][0], v1 = acc[ai][bj][m][1];
            u32x4 o = {pk2(gb[0] * v0[0], gb[1] * v0[1]), pk2(gb[2] * v0[2], gb[3] * v0[3]), pk2(gb[4] * v1[0], gb[5] * v1[1]), pk2(gb[6] * v1[2], gb[7] * v1[3])};
            *(u32x4*)(Q.P + (size_t)row * LDP + col) = o;
          }
        }
      }
    }
    return u.sub == 0;
  }
};
__device__ void phase3a(const Params& P, char* smem) {
  g8::Job g; g.A0 = P.P + GG; g.A1 = P.P + RG; g.B0 = P.Wupg; g.B1 = P.Wupr; g.lda = LDP; g.K = 1024;
  g8::Order S; S.init(64, 4, (int)gridDim.x, (int)blockIdx.x, 2);
  Epi3a E; E.P = &P;
  g8::Unit u; const bool has = S.next(0, u);
  if (has) blk_wait(P.ctr + C_BD + (u.pm >> 3), 20u);
  g8::gemm_phase((G8_LAS unsigned char*)smem, g, S, E);
  if (has) blk_publish(P.ctr + C_PA + u.pm);
  if (blockIdx.x < 256) {
    blk_wait(P.ctr + C_QO, gridDim.x);
    const int r0 = TP + (blockIdx.x >> 6) * 32, c0 = (blockIdx.x & 63) * 16, tid = threadIdx.x;
    const float ua = mini_gemm(P.P + GG, LDP, P.Wupg, 1024, r0, c0, (float*)smem);
    const float ub = mini_gemm(P.P + RG, LDP, P.Wupr, 1024, r0, c0, (float*)smem);
    const int row = r0 + (tid >> 4), col = c0 + (tid & 15);
    const float m = bf2f(P.SG[(size_t)row * 2048 + col]) * ua + bf2f(P.SG[(size_t)row * 2048 + 1024 + col]) * ub;
    P.P[(size_t)row * LDP + col] = f2bf(m);
    blk_publish(P.ctr + C_SA);
  }
}
struct Epi3b {
  const Params* P;
  DI bool operator()(f32x4 (&acc)[2][2][4][2], const g8::Unit& u, int wr, int wc, int fr, int fq) const {
    const Params& Q = *P;
#pragma unroll
    for (int ai = 0; ai < 2; ++ai) {
      f32x4 xv[4][2][2];
#pragma unroll
      for (int m = 0; m < 4; ++m)
#pragma unroll
        for (int bj = 0; bj < 2; ++bj) {
          const int row = u.pm * 256 + ai * 128 + wr * 64 + m * 16 + fr, col = u.pn * 256 + bj * 128 + wc * 32 + 8 * fq;
          const float* xr = Q.x_prompt + (size_t)row * 1024 + col;
          xv[m][bj][0] = *(const f32x4*)xr; xv[m][bj][1] = *(const f32x4*)(xr + 4); }
#pragma unroll
      for (int m = 0; m < 4; ++m)
#pragma unroll
        for (int bj = 0; bj < 2; ++bj) {
          const int row = u.pm * 256 + ai * 128 + wr * 64 + m * 16 + fr, col = u.pn * 256 + bj * 128 + wc * 32 + 8 * fq;
          const f32x4 z0 = acc[ai][bj][m][0] + xv[m][bj][0] * 1.189207115002721f, z1 = acc[ai][bj][m][1] + xv[m][bj][1] * 1.189207115002721f;
          u32x4 o = {pk2(z0[0], z0[1]), pk2(z0[2], z0[3]), pk2(z1[0], z1[1]), pk2(z1[2], z1[3])};
          *(u32x4*)((bf16_t*)(Q.out + O_YP + (size_t)row * 1024) + col) = o; }
    }
    return false;
  }
};
DI void ln_row(const Params& P, int row, int lane) {
  float* yr = P.out + O_YP + (size_t)row * 1024;
  const u32x4 r0 = *(const u32x4*)((const bf16_t*)yr + lane * 8), r1 = *(const u32x4*)((const bf16_t*)yr + 512 + lane * 8);
  float v[16]; { float a[8], b[8]; unpack8(r0, a); unpack8(r1, b);
#pragma unroll
    for (int e = 0; e < 8; ++e) { v[e] = a[e]; v[8 + e] = b[e]; } }
  float s = 0.f;
#pragma unroll
  for (int e = 0; e < 16; ++e) s += v[e];
  const float mean = red64(s) * (1.f / 1024.f); float qq = 0.f;
#pragma unroll
  for (int e = 0; e < 16; ++e) { v[e] -= mean; qq += v[e] * v[e]; }
  const float rs = rsqrtf(red64(qq) * (1.f / 1024.f) + 1e-5f);
#pragma unroll
  for (int q = 0; q < 2; ++q)
#pragma unroll
    for (int hh = 0; hh < 2; ++hh) { const int col = q * 512 + lane * 8 + hh * 4;
      const f32x4 g = *(const f32x4*)(P.ln_g + col), bb = *(const f32x4*)(P.ln_b + col);
      f32x4 x = {v[q * 8 + hh * 4], v[q * 8 + hh * 4 + 1], v[q * 8 + hh * 4 + 2], v[q * 8 + hh * 4 + 3]};
      *(f32x4*)(yr + col) = x * rs * g + bb; }
}
__device__ void phase3bc(const Params& P, char* smem) {
  g8::Job g; g.A0 = P.P; g.A1 = P.P; g.B0 = P.Wout; g.B1 = P.Wout; g.lda = LDP; g.K = 1024;
  g8::Order S; S.init(64, 4, (int)gridDim.x, (int)blockIdx.x, 1);
  Epi3b E; E.P = &P;
  g8::Unit u; const bool has = S.next(0, u);
  if (has) blk_wait(P.ctr + C_PA + u.pm, 4u);
  g8::gemm_phase((G8_LAS unsigned char*)smem, g, S, E);
  if (has) blk_publish(P.ctr + C_PB + u.pm);
  if (blockIdx.x < 256) {
    blk_wait(P.ctr + C_SA, 256u);
    const int r0 = TP + (blockIdx.x >> 6) * 32, c0 = (blockIdx.x & 63) * 16, tid = threadIdx.x;
    const float v = mini_gemm(P.P, LDP, P.Wout, 1024, r0, c0, (float*)smem);
    const int row = r0 + (tid >> 4), col = c0 + (tid & 15);
    ((bf16_t*)(P.out + O_YP + (size_t)row * 1024))[col] = f2bf(v + 1.189207115002721f * P.x_sample[(size_t)(row - TP) * 1024 + col]);
    blk_publish(P.ctr + C_SB);
  }
  const int tid = tid_(), lane = tid & 63, wid = tid >> 6;
  if (has) {
    blk_wait(P.ctr + C_PB + u.pm, 4u);
    for (int i = 0; i < 8; ++i) ln_row(P, u.pm * 256 + u.pn * 64 + wid * 8 + i, lane);
  }
  if (blockIdx.x < 16) {
    blk_wait(P.ctr + C_SB, 256u);
    ln_row(P, TP + blockIdx.x * 8 + wid, lane);
  }
}
__device__ void phase3b(const Params& P, char* smem) { phase3bc(P, smem); }
__device__ void phase3c(const Params& P) {}

DI void grid_bar(unsigned* cnt, unsigned target) {
  asm volatile("s_waitcnt vmcnt(0) lgkmcnt(0)" ::: "memory");
  __syncthreads();
  if (threadIdx.x == 0) {
    __builtin_amdgcn_fence(__ATOMIC_RELEASE, "agent");
    asm volatile("s_waitcnt vmcnt(0)" ::: "memory");
    __hip_atomic_fetch_add(cnt, 1u, __ATOMIC_RELAXED, __HIP_MEMORY_SCOPE_AGENT);
    while (__hip_atomic_load(cnt, __ATOMIC_RELAXED, __HIP_MEMORY_SCOPE_AGENT) < target) __builtin_amdgcn_s_sleep(2);
    __builtin_amdgcn_fence(__ATOMIC_ACQUIRE, "agent");
    asm volatile("s_waitcnt vmcnt(0)" ::: "memory");
  }
  __syncthreads();
}

#if ONE_LAUNCH
__global__ void __launch_bounds__(NT) fwd_megakernel(Params P) {
  extern __shared__ __attribute__((aligned(16))) char smem[];
  cg::grid_group grid = cg::this_grid();
  const unsigned nb = gridDim.x;
  phase0(P, smem); grid.sync();
  phase1(P, smem); grid_bar(P.ctr + 64, nb);
#ifdef PROBE_ROLES
  phase2(P, smem, PROBE_ROLES, true); grid_bar(P.ctr + 64, 2 * nb);
  phase2(P, smem, 7, false); grid_bar(P.ctr + 64, 3 * nb);
  phase3a(P, smem); grid_bar(P.ctr + 64, 4 * nb);
  phase3b(P, smem); grid_bar(P.ctr + 64, 5 * nb);
  phase3c(P);
  return;
#endif
  phase2(P, smem, 7, false);
  phase3a(P, smem);
  phase3bc(P, smem);
}
#else
__global__ void __launch_bounds__(NT) k_phase0(Params P) { extern __shared__ __attribute__((aligned(16))) char smem[]; phase0(P, smem); }
__global__ void __launch_bounds__(NT) k_phase1(Params P) { extern __shared__ __attribute__((aligned(16))) char smem[]; phase1(P, smem); }
__global__ void __launch_bounds__(NT) k_phase2(Params P) { extern __shared__ __attribute__((aligned(16))) char smem[]; phase2(P, smem, 7, false); }
__global__ void __launch_bounds__(NT) k_phase3a(Params P) { extern __shared__ __attribute__((aligned(16))) char smem[]; phase3a(P, smem); }
__global__ void __launch_bounds__(NT) k_phase3b(Params P) { extern __shared__ __attribute__((aligned(16))) char smem[]; phase3b(P, smem); }
__global__ void __launch_bounds__(NT) k_phase3c(Params P) { phase3c(P); }
#endif

extern "C" void kernel_launch(void* const* d_in, const int* in_sizes, int n_in, void* d_out, int out_size, void* d_ws, size_t ws_size,
                              hipStream_t stream) {
  Params P{};
  const float* const* in = (const float* const*)d_in;
  P.x_prompt = in[0]; P.x_sample = in[1]; P.state_gla = in[2]; P.state_rwkv = in[3]; P.state_shift = in[4]; P.w_in = in[5];
  P.gla_w2 = in[6]; P.gla_b = in[7]; P.gla_nw = in[8]; P.mu = in[9]; P.w0 = in[10]; P.w2 = in[11]; P.a0 = in[12]; P.a2 = in[13];
  P.k_k = in[14]; P.k_a = in[15]; P.r_k = in[16]; P.lnx_w = in[17]; P.lnx_b = in[18]; P.w_upg = in[19]; P.w_upr = in[20]; P.w_out = in[21];
  P.ln_g = in[22]; P.ln_b = in[23];
  P.out = (float*)d_out;
  char* ws = (char*)d_ws;
  P.P = (bf16_t*)ws;
  const size_t psz = (size_t)(TT + 128) * LDP * 2;
  P.Wupg = (bf16_t*)(ws + psz); P.Wupr = P.Wupg + 1024 * 1024; P.Wout = P.Wupr + 1024 * 1024;
  P.ctr = (unsigned*)(P.Wout + 1024 * 1024);
  P.xb = (bf16_t*)((float*)d_out + O_GLAS);
  P.Wtin = P.xb + (size_t)(TT + 128) * 1024;
  P.SG = (bf16_t*)d_out;
#if ONE_LAUNCH
  static int grid_blocks = 0;
  if (!grid_blocks) {
    hipFuncSetAttribute((const void*)fwd_megakernel, hipFuncAttributeMaxDynamicSharedMemorySize, SMEM_BYTES);
    int dev = 0, cus = 0, per_cu = 0;
    hipGetDevice(&dev);
    hipDeviceGetAttribute(&cus, hipDeviceAttributeMultiprocessorCount, dev);
    hipOccupancyMaxActiveBlocksPerMultiprocessor(&per_cu, fwd_megakernel, NT, SMEM_BYTES);
    if (per_cu < 1) per_cu = 1;
    grid_blocks = cus;
    if (grid_blocks < 192) grid_blocks = 192;
  }
  void* args[] = {&P};
  hipError_t e = hipLaunchCooperativeKernel((const void*)fwd_megakernel, dim3(grid_blocks), dim3(NT), args, SMEM_BYTES, stream);
  if (e != hipSuccess) fprintf(stderr, "cooperative launch failed: %s (grid %d)\n", hipGetErrorString(e), grid_blocks);
#else
  static bool init = false;
  if (!init) { init = true;
    hipFuncSetAttribute((const void*)k_phase0, hipFuncAttributeMaxDynamicSharedMemorySize, SMEM_BYTES);
    hipFuncSetAttribute((const void*)k_phase1, hipFuncAttributeMaxDynamicSharedMemorySize, SMEM_BYTES);
    hipFuncSetAttribute((const void*)k_phase2, hipFuncAttributeMaxDynamicSharedMemorySize, SMEM_BYTES);
    hipFuncSetAttribute((const void*)k_phase3a, hipFuncAttributeMaxDynamicSharedMemorySize, SMEM_BYTES);
    hipFuncSetAttribute((const void*)k_phase3b, hipFuncAttributeMaxDynamicSharedMemorySize, SMEM_BYTES);
  }
  k_phase0<<<256, NT, SMEM_BYTES, stream>>>(P);
  k_phase1<<<256, NT, SMEM_BYTES, stream>>>(P);
  k_phase2<<<256, NT, SMEM_BYTES, stream>>>(P);
  k_phase3a<<<256, NT, SMEM_BYTES, stream>>>(P);
  k_phase3b<<<256, NT, SMEM_BYTES, stream>>>(P);
  k_phase3c<<<256, NT, 0, stream>>>(P);
#endif
}
```

```cpp
#include <hip/hip_runtime.h>
#include <hip/hip_cooperative_groups.h>
#include <cstdio>
namespace cg = cooperative_groups;

#ifndef ONE_LAUNCH
#define ONE_LAUNCH 1
#endif

typedef unsigned short bf16_t;
typedef short bf16x8 __attribute__((ext_vector_type(8)));
typedef float f32x16 __attribute__((ext_vector_type(16)));
typedef float f32x4 __attribute__((ext_vector_type(4)));
typedef float f32x2 __attribute__((ext_vector_type(2)));
typedef unsigned u32x4 __attribute__((ext_vector_type(4)));
typedef unsigned u32x2 __attribute__((ext_vector_type(2)));
#define DI __device__ __forceinline__
#define MFMA(a, b, c) __builtin_amdgcn_mfma_f32_32x32x16_bf16((a), (b), (c), 0, 0, 0)

constexpr int NT = 512;
constexpr int SMEM_BYTES = 157696;
constexpr int TP = 16384, TT = 16512;
constexpr int LDP = 7424;
constexpr int GQ = 0, GK = 512, GV = 1024, GG = 2048, GA = 3072;
constexpr int RW = 3200;
constexpr int RR = RW, RK = RW + 1024, RV = RW + 2048, RG = RW + 3072, RWL = RW + 4096, RAL = RW + 4160;
constexpr int GATE = 7424;
constexpr int NTILE_N1 = 37, NTILE_M = 129;
constexpr size_t O_YP = 0, O_GLAP = 16908288, O_RWKVP = 17956864, O_SHP = 18481152, O_GLAS = 18514944,
                 O_RWKVS = 35292160, O_SHS = 43680768;

struct Params {
  const float *x_prompt, *x_sample, *state_gla, *state_rwkv, *state_shift, *w_in, *gla_w2, *gla_b, *gla_nw, *mu,
      *w0, *w2, *a0, *a2, *k_k, *k_a, *r_k, *lnx_w, *lnx_b, *w_upg, *w_upr, *w_out, *ln_g, *ln_b;
  float* out;
  bf16_t *P, *Wupg, *Wupr, *Wout, *xb, *Wtin, *SG;
  unsigned* ctr;
};

DI int tid_() { int t = threadIdx.x; asm volatile("" : "+v"(t)); return t; }
DI float bf2f(bf16_t u) { return __uint_as_float((unsigned)u << 16); }
DI float bflo(unsigned u) { return __uint_as_float(u << 16); }
DI float bfhi(unsigned u) { return __uint_as_float(u & 0xffff0000u); }
typedef __bf16 bf16x2_t __attribute__((ext_vector_type(2)));
DI unsigned pk2(float lo, float hi) { f32x2 v = {lo, hi}; return __builtin_bit_cast(unsigned, __builtin_convertvector(v, bf16x2_t)); }
DI bf16_t f2bf(float x) { return (bf16_t)(pk2(x, x) & 0xffffu); }
DI float sigm(float x) { return __builtin_amdgcn_rcpf(1.f + __expf(-x)); }
DI float silu(float x) { return x * __builtin_amdgcn_rcpf(1.f + __expf(-x)); }
DI float logsig(float x) { return fminf(x, 0.f) - __logf(1.f + __expf(-fabsf(x))); }
DI float tanh_(float x) { float e = __expf(2.f * x); return 1.f - 2.f * __builtin_amdgcn_rcpf(e + 1.f); }
DI void unpack8(u32x4 v, float (&f)[8]) {
  f[0] = bflo(v[0]); f[1] = bfhi(v[0]); f[2] = bflo(v[1]); f[3] = bfhi(v[1]);
  f[4] = bflo(v[2]); f[5] = bfhi(v[2]); f[6] = bflo(v[3]); f[7] = bfhi(v[3]);
}
DI u32x4 pack8(const float (&f)[8]) { u32x4 o = {pk2(f[0], f[1]), pk2(f[2], f[3]), pk2(f[4], f[5]), pk2(f[6], f[7])}; return o; }
DI void ld8f(const float* p, float (&f)[8]) {
  f32x4 a = *(const f32x4*)p, b = *(const f32x4*)(p + 4);
  f[0] = a[0]; f[1] = a[1]; f[2] = a[2]; f[3] = a[3]; f[4] = b[0]; f[5] = b[1]; f[6] = b[2]; f[7] = b[3];
}
DI float red8(float x) {
  x += __builtin_bit_cast(float, __builtin_amdgcn_update_dpp(0, __builtin_bit_cast(int, x), 0xB1, 0xF, 0xF, true));
  x += __builtin_bit_cast(float, __builtin_amdgcn_update_dpp(0, __builtin_bit_cast(int, x), 0x4E, 0xF, 0xF, true));
  x += __builtin_bit_cast(float, __builtin_amdgcn_update_dpp(0, __builtin_bit_cast(int, x), 0x141, 0xF, 0xF, true));
  return x;
}
DI float red64(float x) {
  for (int o = 32; o > 0; o >>= 1) x += __shfl_xor(x, o);
  return x;
}
DI int crow(int reg, int h) { return (reg & 3) + 8 * (reg >> 2) + 4 * h; }
DI bf16x8 pack_acc(const f32x16& x, int s) {
  u32x4 p = {pk2(x[8 * s + 0], x[8 * s + 1]), pk2(x[8 * s + 2], x[8 * s + 3]), pk2(x[8 * s + 4], x[8 * s + 5]), pk2(x[8 * s + 6], x[8 * s + 7])};
  return __builtin_bit_cast(bf16x8, p);
}

__device__ void phase0(const Params& P, char* smem) {
  const int tid = tid_(), nb = gridDim.x, bid = blockIdx.x;
  if (bid == 0) for (int i = tid; i < 1024; i += NT) P.ctr[i] = 0u;
  { const int stride = nb * NT; int i = bid * NT + tid;
    for (; i + 3 * stride < TT * 128; i += 4 * stride) {
      float f[4][8];
#pragma unroll
      for (int u = 0; u < 4; ++u) { const int ii = i + u * stride, row = ii >> 7, c8 = (ii & 127) * 8;
        ld8f(row < TP ? P.x_prompt + (size_t)row * 1024 + c8 : P.x_sample + (size_t)(row - TP) * 1024 + c8, f[u]); }
#pragma unroll
      for (int u = 0; u < 4; ++u) { const int ii = i + u * stride, row = ii >> 7, c8 = (ii & 127) * 8; *(u32x4*)(P.xb + (size_t)row * 1024 + c8) = pack8(f[u]); }
    }
    for (; i < TT * 128; i += stride) { const int row = i >> 7, c8 = (i & 127) * 8; float f[8];
      ld8f(row < TP ? P.x_prompt + (size_t)row * 1024 + c8 : P.x_sample + (size_t)(row - TP) * 1024 + c8, f);
      *(u32x4*)(P.xb + (size_t)row * 1024 + c8) = pack8(f); } }
  for (int i = bid * NT + tid; i < 128 * 128; i += nb * NT) { u32x4 z = {0u, 0u, 0u, 0u}; *(u32x4*)(P.xb + (size_t)TT * 1024 + (size_t)i * 8) = z; }
  float* tile = (float*)smem;
  const int njobs = 16 * 148 + 3 * 256;
  const int kk0 = tid >> 4, nn = (tid & 15) * 4;
  f32x4 v0, v1;
  auto job_load = [&](int j) {
    const float* src; int ldsrc, k0, n0; bool isin;
    if (j < 16 * 148) { isin = true; src = P.w_in; ldsrc = 9360; k0 = (j & 15) * 64; n0 = (j >> 4) * 64; }
    else { int jj = j - 16 * 148; const int w = jj >> 8; jj &= 255; isin = false; ldsrc = 1024; src = w == 0 ? P.w_upg : (w == 1 ? P.w_upr : P.w_out); k0 = (jj & 15) * 64; n0 = (jj >> 4) * 64; }
    const int np = n0 + nn; int n = np;
    if (isin) n = np < 3088 ? np : (np < 3200 ? -1 : np - 112);
    v0 = (f32x4){0.f, 0.f, 0.f, 0.f}; v1 = v0;
    if (n >= 0) { v0 = *(const f32x4*)(src + (size_t)(k0 + kk0) * ldsrc + n); v1 = *(const f32x4*)(src + (size_t)(k0 + kk0 + 32) * ldsrc + n); }
  };
  if (bid < njobs) job_load(bid);
  for (int j = bid; j < njobs; j += nb) {
    bf16_t* dst; int k0, n0;
    if (j < 16 * 148) { dst = P.Wtin; k0 = (j & 15) * 64; n0 = (j >> 4) * 64; }
    else { int jj = j - 16 * 148; const int w = jj >> 8; jj &= 255; dst = w == 0 ? P.Wupg : (w == 1 ? P.Wupr : P.Wout); k0 = (jj & 15) * 64; n0 = (jj >> 4) * 64; }
    tile[kk0 * 65 + nn] = v0[0]; tile[kk0 * 65 + nn + 1] = v0[1]; tile[kk0 * 65 + nn + 2] = v0[2]; tile[kk0 * 65 + nn + 3] = v0[3];
    tile[(kk0 + 32) * 65 + nn] = v1[0]; tile[(kk0 + 32) * 65 + nn + 1] = v1[1]; tile[(kk0 + 32) * 65 + nn + 2] = v1[2]; tile[(kk0 + 32) * 65 + nn + 3] = v1[3];
    if (j + nb < njobs) job_load(j + nb);
    __syncthreads();
    { const int n2 = tid >> 3, ks = (tid & 7) * 8; float f[8];
#pragma unroll
      for (int e = 0; e < 8; ++e) f[e] = tile[(ks + e) * 65 + n2];
      *(u32x4*)(dst + (size_t)(n0 + n2) * 1024 + k0 + ks) = pack8(f); }
    __syncthreads();
  }
}

constexpr int ROWB = 144;
namespace g8 {
#define G8_LAS __attribute__((address_space(3)))
constexpr int BM = 256, BK = 64, HALF = 128, HTB = HALF * BK * 2, STAGE_BYTES = 8 * HTB, NXCD = 8, WGM = 8;
DI int lds_byte(int r, int c) { const int st = (r >> 4) * 2 + (c >> 5), rr = r & 15, cc = c & 31, ob = rr * 64 + cc * 2; return st * 1024 + (ob ^ (((ob >> 9) & 1) << 5)); }
DI void stage_rc(int b, int& R, int& C) { const int st = b / 1024, sb = b % 1024, swz = sb ^ (((sb >> 9) & 1) << 5); R = (st >> 1) * 16 + swz / 64; C = (st & 1) * 32 + (swz % 64) / 2; }
DI int perm32(int rho) { const int n = rho >> 4, i = rho & 15; return 8 * (i >> 2) + 4 * n + (i & 3); }
struct Unit { int pm, pn, sub; };
struct Job { const bf16_t* A0; const bf16_t* A1; const bf16_t* B0; const bf16_t* B1; int lda, K; };
struct Order {
  int nM, nN, nwg, G, c, nsub;
  DI void init(int nM_, int nN_, int G_, int c_, int nsub_) { nM = nM_; nN = nN_; nwg = nM * nN; G = G_; c = c_; nsub = nsub_; }
  DI bool next(int i, Unit& u) const {
    const int ti = nsub == 2 ? (i >> 1) : i; u.sub = nsub == 2 ? (i & 1) : 0;
    const long L = (long)ti * G + c; if (L >= nwg) return false;
    int wgid = (int)L; { const int q = nwg / NXCD, r = nwg % NXCD, xcd = wgid % NXCD, off = wgid / NXCD; wgid = (xcd < r ? xcd * (q + 1) : r * (q + 1) + (xcd - r) * q) + off; }
    const int nig = WGM * nN, gid = wgid / nig, fm = gid * WGM, gsz = (nM - fm) < WGM ? (nM - fm) : WGM;
    u.pm = fm + ((wgid % nig) % gsz); u.pn = (wgid % nig) / gsz; return true;
  }
};
template <class Epi>
DI void gemm_phase(G8_LAS unsigned char* lds, const Job g, const Order& S, Epi& E) {
  const int tid = tid_(), wid = __builtin_amdgcn_readfirstlane(tid >> 6), lane = tid & 63, wr = wid >> 2, wc = wid & 3, fr = lane & 15, fq = lane >> 4;
  const int K = g.K, nt = K / BK;
  unsigned voffA[2], voffB[2];
#pragma unroll
  for (int i = 0; i < 2; ++i) { int R, C; stage_rc(tid * 16 + i * 8192, R, C); const int Rb = (R & ~31) + perm32(R & 31);
    voffA[i] = (unsigned)(R * g.lda + C) * 2u; voffB[i] = (unsigned)(Rb * K + C) * 2u; }
  const size_t kstep = (size_t)(BK * 2);
  const size_t hstepA = (size_t)HALF * g.lda * 2, hstepB = (size_t)HALF * K * 2;
  const size_t tstepA = 2 * hstepA, tstepB = 2 * hstepB;
  const unsigned ldsw = (unsigned)wid * 1024u;
  const int aoff = lds_byte(wr * 64 + fr, fq * 8), boff = lds_byte(wc * 32 + fr, fq * 8);
#define G8_SA(b, h) (((b) * 2 + (h)) * HTB)
#define G8_SB(b, h) ((4 + (b) * 2 + (h)) * HTB)
#define G8_STAGE(bufoff, gbase, voff) do { _Pragma("unroll") for (int _i = 0; _i < 2; ++_i) \
    __builtin_amdgcn_global_load_lds((const unsigned*)((const char*)(gbase) + (voff)[_i]), (G8_LAS unsigned*)(lds + (bufoff) + ldsw + _i * 8192), 16, 0, 0); } while (0)
#define G8_LDA(dst, b, h) do { _Pragma("unroll") for (int m = 0; m < 4; ++m) _Pragma("unroll") for (int k = 0; k < 2; ++k) dst[m][k] = *(const G8_LAS bf16x8*)(lds + G8_SA(b, h) + aoff + m * 2048 + k * 1024); } while (0)
#define G8_LDB(dst, b, h) do { _Pragma("unroll") for (int n = 0; n < 2; ++n) _Pragma("unroll") for (int k = 0; k < 2; ++k) dst[n][k] = *(const G8_LAS bf16x8*)(lds + G8_SB(b, h) + boff + n * 2048 + k * 1024); } while (0)
#define G8_MMA(ai, bj, At, Bt) do { __builtin_amdgcn_s_setprio(1); _Pragma("unroll") for (int m = 0; m < 4; ++m) _Pragma("unroll") for (int n = 0; n < 2; ++n) _Pragma("unroll") for (int k = 0; k < 2; ++k) \
    acc[ai][bj][m][n] = __builtin_amdgcn_mfma_f32_16x16x32_bf16(Bt[n][k], At[m][k], acc[ai][bj][m][n], 0, 0, 0); __builtin_amdgcn_s_setprio(0); } while (0)
#define G8_WAIT_V(n) asm volatile("s_waitcnt vmcnt(" #n ")" ::: "memory")
#define G8_WAIT_L(n) asm volatile("s_waitcnt lgkmcnt(" #n ")" ::: "memory")
#define G8_BAR __builtin_amdgcn_s_barrier()
#define G8_SCHED __builtin_amdgcn_sched_barrier(0)
  Unit cur, nxt; int ui = 0;
  if (!S.next(0, cur)) return;
  f32x4 acc[2][2][4][2];
#pragma unroll
  for (int a = 0; a < 2; ++a)
#pragma unroll
    for (int b = 0; b < 2; ++b)
#pragma unroll
      for (int m = 0; m < 4; ++m)
#pragma unroll
        for (int n = 0; n < 2; ++n) acc[a][b][m][n] = (f32x4){0.f, 0.f, 0.f, 0.f};
  bf16x8 At[4][2], B0[2][2], B1[2][2];
  const char* cA = (const char*)(cur.sub ? g.A1 : g.A0) + (size_t)cur.pm * tstepA; const char* cB = (const char*)(cur.sub ? g.B1 : g.B0) + (size_t)cur.pn * tstepB;
  G8_STAGE(G8_SB(0, 0), cB, voffB); G8_STAGE(G8_SA(0, 0), cA, voffA); G8_STAGE(G8_SB(0, 1), cB + hstepB, voffB); G8_STAGE(G8_SA(0, 1), cA + hstepA, voffA);
  if (wr == 1) G8_BAR;
  G8_WAIT_V(4); G8_BAR;
  G8_STAGE(G8_SB(1, 0), cB + kstep, voffB); G8_STAGE(G8_SA(1, 0), cA + kstep, voffA); G8_STAGE(G8_SB(1, 1), cB + hstepB + kstep, voffB);
  G8_WAIT_V(6); G8_BAR;
  for (;;) {
    const bool has_next = S.next(ui + 1, nxt);
    const char* nA = has_next ? (const char*)(nxt.sub ? g.A1 : g.A0) + (size_t)nxt.pm * tstepA : cA;
    const char* nB = has_next ? (const char*)(nxt.sub ? g.B1 : g.B0) + (size_t)nxt.pn * tstepB : cB;
    for (int t = 0; t < nt; t += 2) {
      const bool last = (t == nt - 2);
      const char* a1 = cA + (size_t)(t + 1) * kstep;
      const char* a2 = last ? nA : cA + (size_t)(t + 2) * kstep; const char* b2 = last ? nB : cB + (size_t)(t + 2) * kstep;
      const char* a3 = a2 + kstep; const char* b3 = b2 + kstep;
      G8_LDB(B0, 0, 0); G8_SCHED; G8_LDA(At, 0, 0); G8_STAGE(G8_SA(1, 1), a1 + hstepA, voffA);
      G8_WAIT_L(8); G8_BAR; G8_WAIT_L(0); G8_MMA(0, 0, At, B0); G8_BAR; G8_SCHED;
      G8_LDB(B1, 0, 1); G8_STAGE(G8_SB(0, 0), b2, voffB);
      G8_BAR; G8_WAIT_L(0); G8_MMA(0, 1, At, B1); G8_BAR;
      G8_LDA(At, 0, 1); G8_STAGE(G8_SA(0, 0), a2, voffA);
      G8_BAR; G8_WAIT_L(0); G8_MMA(1, 0, At, B0); G8_BAR; G8_SCHED;
      G8_STAGE(G8_SB(0, 1), b2 + hstepB, voffB);
      G8_WAIT_V(6); G8_BAR; G8_MMA(1, 1, At, B1); G8_BAR;
      G8_LDB(B0, 1, 0); G8_SCHED; G8_LDA(At, 1, 0); G8_STAGE(G8_SA(0, 1), a2 + hstepA, voffA);
      G8_WAIT_L(8); G8_BAR; G8_WAIT_L(0); G8_MMA(0, 0, At, B0); G8_BAR; G8_SCHED;
      G8_LDB(B1, 1, 1); G8_STAGE(G8_SB(1, 0), b3, voffB);
      G8_BAR; G8_WAIT_L(0); G8_MMA(0, 1, At, B1); G8_BAR;
      G8_LDA(At, 1, 1); G8_STAGE(G8_SA(1, 0), a3, voffA);
      G8_BAR; G8_WAIT_L(0); G8_MMA(1, 0, At, B0); G8_BAR; G8_SCHED;
      G8_STAGE(G8_SB(1, 1), b3 + hstepB, voffB);
      G8_WAIT_V(6); G8_BAR; G8_MMA(1, 1, At, B1); G8_BAR;
    }
    const bool keep = E(acc, cur, wr, wc, fr, fq);
    if (!has_next) break;
    if (!keep) {
#pragma unroll
      for (int a = 0; a < 2; ++a)
#pragma unroll
        for (int b = 0; b < 2; ++b)
#pragma unroll
          for (int m = 0; m < 4; ++m)
#pragma unroll
            for (int n = 0; n < 2; ++n) acc[a][b][m][n] = (f32x4){0.f, 0.f, 0.f, 0.f};
    }
    cur = nxt; cA = nA; cB = nB; ++ui;
  }
  G8_WAIT_V(0);
  if (wr == 0) G8_BAR;
  G8_BAR;
#undef G8_SA
#undef G8_SB
#undef G8_STAGE
#undef G8_LDA
#undef G8_LDB
#undef G8_MMA
#undef G8_WAIT_V
#undef G8_WAIT_L
#undef G8_BAR
#undef G8_SCHED
}
}

struct Epi1 {
  const Params* P; int pn_off;
  DI bool operator()(f32x4 (&acc)[2][2][4][2], const g8::Unit& u0, int wr, int wc, int fr, int fq) const {
    const Params& Q = *P; g8::Unit u = u0; u.pn += pn_off;
#pragma unroll
    for (int ai = 0; ai < 2; ++ai)
#pragma unroll
      for (int m = 0; m < 4; ++m) {
        const int row = u.pm * 256 + ai * 128 + wr * 64 + m * 16 + fr;
#pragma unroll
        for (int bj = 0; bj < 2; ++bj) {
          const int col = u.pn * 256 + bj * 128 + wc * 32 + 8 * fq;
          const f32x4 v0 = acc[ai][bj][m][0], v1 = acc[ai][bj][m][1];
          if (col < GATE) {
            u32x4 o = {pk2(v0[0], v0[1]), pk2(v0[2], v0[3]), pk2(v1[0], v1[1]), pk2(v1[2], v1[3])};
            *(u32x4*)(Q.P + (size_t)row * LDP + col) = o;
            if (col >= RW && row < TT) {
              float* d = nullptr;
              if (row >= TP) d = Q.out + O_SHS + (size_t)(row - TP) * 4224 + (col - RW);
              else if ((row & 2047) == 2047) d = Q.out + O_SHP + (size_t)(row >> 11) * 4224 + (col - RW);
              if (d) { *(f32x4*)d = v0; *(f32x4*)(d + 4) = v1; }
            }
          } else if (row < TT) {
            u32x4 o = {pk2(sigm(v0[0]), sigm(v0[1])), pk2(sigm(v0[2]), sigm(v0[3])), pk2(sigm(v1[0]), sigm(v1[1])), pk2(sigm(v1[2]), sigm(v1[3]))};
            *(u32x4*)(Q.SG + (size_t)row * 2048 + (col - GATE)) = o;
          }
        }
      }
    return false;
  }
};
__device__ void phase1(const Params& P, char* smem) {
  g8::Job g; g.A0 = P.xb; g.A1 = P.xb; g.B0 = P.Wtin; g.B1 = P.Wtin; g.lda = 1024; g.K = 1024;
  g8::Order S; S.init(65, NTILE_N1 - 8, (int)gridDim.x, (int)blockIdx.x, 1);
  Epi1 E; E.P = &P; E.pn_off = 0;
  g8::gemm_phase((G8_LAS unsigned char*)smem, g, S, E);
}
__device__ void phase1_gates(const Params& P, char* smem, int nblk, int c) {
  g8::Job g; g.A0 = P.xb; g.A1 = P.xb; g.B0 = P.Wtin + (size_t)(NTILE_N1 - 8) * 256 * 1024; g.B1 = g.B0; g.lda = 1024; g.K = 1024;
  g8::Order S; S.init(65, 8, nblk, c, 1);
  Epi1 E; E.P = &P; E.pn_off = NTILE_N1 - 8;
  g8::gemm_phase((G8_LAS unsigned char*)smem, g, S, E);
}

constexpr int G_QT = 0, G_KT = 17408, G_KHT = 34816, G_VT = 53248, G_AM = 90112, G_ALR = 99328, G_BL = 103424, G_SEG = 103936, G_SSQ = 105984, G_B = 108032, G_EBL = 141824, G_NW = 142336;
__device__ void gla_prompt_unit(const Params& P, char* smem, int b, int hd, bool dry) {
  const int tid = tid_(), lane = tid & 63, wid = __builtin_amdgcn_readfirstlane(tid >> 6), h = lane >> 5, l31 = lane & 31;
  float* ALR = (float*)(smem + G_ALR); float* BL = (float*)(smem + G_BL); float* SEG = (float*)(smem + G_SEG); float* SSQ = (float*)(smem + G_SSQ);
  float* Bc = (float*)(smem + G_B);
  float* EBL = (float*)(smem + G_EBL);
  float* NW = (float*)(smem + G_NW);
  if (tid < 256) NW[tid] = P.gla_nw[tid];
  const int dk = tid & 127, seg = tid >> 7;
  const int li = tid & 63, lg = tid >> 6;
  const int i6 = tid >> 3, sg8 = tid & 7;
  float w2c[16];
#pragma unroll
  for (int j = 0; j < 16; ++j) w2c[j] = P.gla_w2[j * 512 + hd * 128 + dk];
  const float bias = P.gla_b[hd * 128 + dk];
  f32x16 S[4];
#pragma unroll
  for (int kb = 0; kb < 4; ++kb)
#pragma unroll
    for (int e = 0; e < 16; ++e) S[kb][e] = 0.f;
  const float qscale = 0.08838834764831845f;
  u32x4 rq[2], rk[2], rv[4], rga[4]; u32x2 ralr = {0u, 0u};
  u32x4 ost[4];
  auto flush_out = [&](int c) {
    if (dry) return;
    bf16_t* op = P.P + ((size_t)b * 2048 + c * 64 + i6) * LDP + GG + hd * 256 + 32 * sg8;
#pragma unroll
    for (int q4 = 0; q4 < 4; ++q4) *(u32x4*)(op + 8 * q4) = ost[q4];
  };
  auto issue_qkv = [&](int c) {
    const bf16_t* rowp = P.P + ((size_t)b * 2048 + c * 64 + li) * LDP;
#pragma unroll
    for (int it = 0; it < 2; ++it) { rq[it] = *(const u32x4*)(rowp + GQ + hd * 128 + 8 * (lg + 8 * it)); rk[it] = *(const u32x4*)(rowp + GK + hd * 128 + 8 * (lg + 8 * it)); }
#pragma unroll
    for (int it = 0; it < 4; ++it) rv[it] = *(const u32x4*)(rowp + GV + hd * 256 + 8 * (lg + 8 * it));
  };
  auto issue_alr = [&](int c) {
    if (tid < 256) ralr = *(const u32x2*)(P.P + ((size_t)b * 2048 + c * 64 + (tid >> 2)) * LDP + GA + (tid & 3) * 4);
  };
  auto issue_ga = [&](int c) {
    const bf16_t* gp = P.P + ((size_t)b * 2048 + c * 64 + i6) * LDP + GG + hd * 256 + 32 * sg8;
#pragma unroll
    for (int q4 = 0; q4 < 4; ++q4) rga[q4] = *(const u32x4*)(gp + 8 * q4);
  };
  issue_alr(0);

  for (int c = 0; c < 32; ++c) {
    const size_t rb = (size_t)b * 2048 + c * 64;
    issue_qkv(c);
    if (tid < 256) { f32x4 f = {bflo(ralr[0]), bfhi(ralr[0]), bflo(ralr[1]), bfhi(ralr[1])}; *(f32x4*)(ALR + (tid >> 2) * 16 + (tid & 3) * 4) = f; }
    __syncthreads();
    { float bc[16]; float run = 0.f;
#pragma unroll
      for (int ii = 0; ii < 16; ++ii) {
        const int i = 16 * seg + ii; float x = bias;
#pragma unroll
        for (int j4 = 0; j4 < 4; ++j4) { const f32x4 a = *(const f32x4*)(ALR + i * 16 + 4 * j4);
          x += a[0] * w2c[4 * j4] + a[1] * w2c[4 * j4 + 1] + a[2] * w2c[4 * j4 + 2] + a[3] * w2c[4 * j4 + 3]; }
        run += logsig(x) * 0.0625f; bc[ii] = run;
      }
      SEG[seg * 128 + dk] = run;
      __syncthreads();
      float off = 0.f, tot = 0.f;
#pragma unroll
      for (int s = 0; s < 4; ++s) { const float v = SEG[s * 128 + dk]; tot += v; if (s < seg) off += v; }
      if (seg == 0) { BL[dk] = tot; EBL[dk] = __expf(tot); }
#pragma unroll
      for (int ii = 0; ii < 16; ++ii) Bc[(16 * seg + ii) * 132 + dk] = bc[ii] + off; }
    __syncthreads();
#pragma unroll
    for (int it = 0; it < 2; ++it) {
      const int dk0 = 8 * (lg + 8 * it); float qf[8], kf[8], bb[8], tt[8], qt[8], kt[8];
      unpack8(rq[it], qf); unpack8(rk[it], kf); ld8f(Bc + li * 132 + dk0, bb); ld8f(EBL + dk0, tt);
#pragma unroll
      for (int e = 0; e < 8; ++e) { qt[e] = qf[e] * qscale * __expf(bb[e]); kt[e] = kf[e] * __expf(-bb[e]);
        *(bf16_t*)(smem + G_KHT + (dk0 + e) * ROWB + li * 2) = f2bf(kt[e] * tt[e]); }
      *(u32x4*)(smem + G_QT + li * 272 + dk0 * 2) = pack8(qt); *(u32x4*)(smem + G_KT + li * 272 + dk0 * 2) = pack8(kt);
      __builtin_amdgcn_sched_barrier(0);
    }
#pragma unroll
    for (int it = 0; it < 4; ++it) { const int dv0 = 8 * (lg + 8 * it);
#pragma unroll
      for (int e = 0; e < 4; ++e) { *(bf16_t*)(smem + G_VT + (dv0 + 2 * e) * ROWB + li * 2) = (bf16_t)(rv[it][e] & 0xffffu); *(bf16_t*)(smem + G_VT + (dv0 + 2 * e + 1) * ROWB + li * 2) = (bf16_t)(rv[it][e] >> 16); } }
    if (c > 0) flush_out(c - 1);
    __syncthreads();
    issue_ga(c);
    f32x16 o[2];
#pragma unroll
    for (int ib = 0; ib < 2; ++ib)
#pragma unroll
      for (int e = 0; e < 16; ++e) o[ib][e] = 0.f;
#pragma unroll
    for (int kb = 0; kb < 4; ++kb)
#pragma unroll
      for (int s = 0; s < 2; ++s) {
        const bf16x8 sp = pack_acc(S[kb], s);
#pragma unroll
        for (int ib = 0; ib < 2; ++ib) {
          const char* qp = smem + G_QT + (32 * ib + l31) * 272 + (32 * kb + 16 * s + 4 * h) * 2;
          const u32x2 q0 = *(const u32x2*)qp, q1 = *(const u32x2*)(qp + 16);
          u32x4 qq = {q0[0], q0[1], q1[0], q1[1]};
          o[ib] = MFMA(sp, __builtin_bit_cast(bf16x8, qq), o[ib]);
        }
      }
    if (wid < 4) {
      const int bi = wid >> 1, bj = wid & 1;
      f32x16 am;
#pragma unroll
      for (int e = 0; e < 16; ++e) am[e] = 0.f;
      if (wid != 1) {
#pragma unroll
        for (int ks = 0; ks < 8; ++ks) {
          const bf16x8 qf = *(const bf16x8*)(smem + G_QT + (32 * bi + l31) * 272 + ks * 32 + h * 16);
          const bf16x8 kf = *(const bf16x8*)(smem + G_KT + (32 * bj + l31) * 272 + ks * 32 + h * 16);
          am = MFMA(kf, qf, am);
        }
      }
      const int i = 32 * bi + l31;
#pragma unroll
      for (int g4 = 0; g4 < 4; ++g4) { float v[4];
#pragma unroll
        for (int e = 0; e < 4; ++e) { const int j = 32 * bj + 8 * g4 + 4 * h + e; v[e] = (j <= i) ? am[4 * g4 + e] : 0.f; }
        u32x2 ov = {pk2(v[0], v[1]), pk2(v[2], v[3])};
        *(u32x2*)(smem + G_AM + i * ROWB + (32 * bj + 8 * g4 + 4 * h) * 2) = ov; }
    }
    __syncthreads();
    { bf16x8 vf[4];
#pragma unroll
      for (int ks = 0; ks < 4; ++ks) vf[ks] = *(const bf16x8*)(smem + G_VT + (32 * wid + l31) * ROWB + ks * 32 + h * 16);
#pragma unroll
      for (int ib = 0; ib < 2; ++ib)
#pragma unroll
        for (int ks = 0; ks < 4; ++ks) { const bf16x8 af = *(const bf16x8*)(smem + G_AM + (32 * ib + l31) * ROWB + ks * 32 + h * 16);
          o[ib] = MFMA(vf[ks], af, o[ib]); }
#pragma unroll
      for (int kb = 0; kb < 4; ++kb) {
#pragma unroll
        for (int g4 = 0; g4 < 4; ++g4) { const f32x4 bl = *(const f32x4*)(EBL + 32 * kb + 8 * g4 + 4 * h);
#pragma unroll
          for (int e = 0; e < 4; ++e) S[kb][4 * g4 + e] *= bl[e]; }
#pragma unroll
        for (int ks = 0; ks < 4; ++ks) { const bf16x8 kf = *(const bf16x8*)(smem + G_KHT + (32 * kb + l31) * ROWB + ks * 32 + h * 16);
          S[kb] = MFMA(kf, vf[ks], S[kb]); }
      } }
#pragma unroll
    for (int ib = 0; ib < 2; ++ib) { float s = 0.f;
#pragma unroll
      for (int e = 0; e < 16; ++e) s += o[ib][e] * o[ib][e];
      s += __shfl_xor(s, 32);
      if (lane < 32) SSQ[wid * 64 + 32 * ib + lane] = s; }
    __syncthreads();
    if (c + 1 < 32) issue_alr(c + 1);
#pragma unroll
    for (int ib = 0; ib < 2; ++ib)
#pragma unroll
      for (int g4 = 0; g4 < 4; ++g4) { u32x2 ov = {pk2(o[ib][4 * g4], o[ib][4 * g4 + 1]), pk2(o[ib][4 * g4 + 2], o[ib][4 * g4 + 3])};
        *(u32x2*)(smem + (32 * ib + l31) * 528 + (32 * wid + 8 * g4 + 4 * h) * 2) = ov; }
    __syncthreads();
    { float ss = 0.f;
#pragma unroll
      for (int w = 0; w < 8; ++w) ss += SSQ[w * 64 + i6];
      const float rs = rsqrtf(ss * (1.f / 256.f) + 1e-5f);
#pragma unroll
      for (int q4 = 0; q4 < 4; ++q4) { const int dv0 = 32 * sg8 + 8 * q4;
        float ov[8], gv[8], nw[8];
        unpack8(*(const u32x4*)(smem + i6 * 528 + dv0 * 2), ov);
        unpack8(rga[q4], gv);
        ld8f(NW + dv0, nw);
#pragma unroll
        for (int e = 0; e < 8; ++e) ov[e] = ov[e] * rs * nw[e] * silu(gv[e]);
        ost[q4] = pack8(ov); }
    }
  }
  flush_out(31);
#pragma unroll
  for (int kb = 0; kb < 4; ++kb)
#pragma unroll
    for (int e = 0; e < 16; ++e)
      P.out[O_GLAP + ((size_t)(b * 4 + hd) * 128 + 32 * kb + crow(e, h)) * 256 + 32 * wid + l31] = S[kb][e];
  __syncthreads();
}

constexpr int PB_KAP = 0, PB_RHO = 4608, PB_ALPT = 9216, PB_BETT = 14336, PB_VT = 19456, PB_TT = 24576, PB_NB = 27136, PB_MA = 29696, PB_MB = 32256, PB_CT = 34816, PB_SIZE = 35328;
constexpr int X_PB = 0, X_Y = 70656, X_GB = 87040, X_W2T = 95232, X_A2T = 104448, X_LIN = 113664, X_ARG = 122880, X_C3 = 139264, X_SEG = 140288,
              X_CONST = 142336, X_TS = 145664;
constexpr int R40 = 80;
DI bf16x8 ld_perm(const char* p) { const u32x2 q0 = *(const u32x2*)p, q1 = *(const u32x2*)(p + 16); u32x4 q = {q0[0], q0[1], q1[0], q1[1]}; return __builtin_bit_cast(bf16x8, q); }
DI void unpack4(u32x2 v, float (&f)[4]) { f[0] = bflo(v[0]); f[1] = bfhi(v[0]); f[2] = bflo(v[1]); f[3] = bfhi(v[1]); }
DI u32x2 pack4(const float (&f)[4]) { u32x2 o = {pk2(f[0], f[1]), pk2(f[2], f[3])}; return o; }
DI void ld4f(const float* p, float (&f)[4]) { const f32x4 a = *(const f32x4*)p; f[0] = a[0]; f[1] = a[1]; f[2] = a[2]; f[3] = a[3]; }
DI float red16(float x) {
  x = red8(x);
  x += __builtin_bit_cast(float, __builtin_amdgcn_update_dpp(0, __builtin_bit_cast(int, x), 0x140, 0xF, 0xF, true));
  return x;
}
__device__ void rwkv_prompt_unit(const Params& P, char* smem, int b, int hd, bool dry) {
  const int tid = tid_(), lane = tid & 63, wid = __builtin_amdgcn_readfirstlane(tid >> 6), h = lane >> 5, l31 = lane & 31;
  const int t = tid >> 4, cq = tid & 15, c4 = cq * 4, hc = hd * 64 + c4;
  { const int j = tid >> 3; const int cc8 = (tid & 7) * 8; float f[8], g[8];
    ld8f(P.w2 + j * 1024 + hd * 64 + cc8, f); ld8f(P.a2 + j * 1024 + hd * 64 + cc8, g);
#pragma unroll
    for (int e = 0; e < 8; ++e) { *(bf16_t*)(smem + X_W2T + (cc8 + e) * ROWB + j * 2) = f2bf(f[e]); *(bf16_t*)(smem + X_A2T + (cc8 + e) * ROWB + j * 2) = f2bf(g[e]); } }
  f32x16 St[2];
#pragma unroll
  for (int kb = 0; kb < 2; ++kb)
#pragma unroll
    for (int e = 0; e < 16; ++e) St[kb][e] = 0.f;
  float* CONSTS = (float*)(smem + X_CONST);
  if (tid < 64) { const int c = hd * 64 + tid;
    CONSTS[tid] = P.mu[c]; CONSTS[64 + tid] = P.mu[1024 + c]; CONSTS[128 + tid] = P.mu[2048 + c]; CONSTS[192 + tid] = P.mu[3072 + c];
    CONSTS[256 + tid] = P.w0[c]; CONSTS[320 + tid] = P.a0[c]; CONSTS[384 + tid] = P.k_k[c]; CONSTS[448 + tid] = P.k_a[c]; CONSTS[512 + tid] = P.r_k[c];
    CONSTS[576 + tid] = P.lnx_w[c]; CONSTS[640 + tid] = P.lnx_b[c]; CONSTS[704 + tid] = P.mu[4096 + tid]; CONSTS[768 + tid] = P.mu[4160 + tid]; }
  __syncthreads();

  for (int it = -1; it < 65; ++it) {
    const int kp = it + 1;
    const bool do_pre = kp < 64, do_post = it >= 1, do_cons = it >= 0 && it < 64;
    u32x2 Lw, La, Lwq, Laq, Lr, Lk, Lv, Lg, Lrq, Lkq, Lvq, Lgq;
    const size_t r = (size_t)b * 2048 + (size_t)(do_pre ? kp : 0) * 32 + t;
    const bool first = (kp == 0 && t == 0);
    const int p = kp & 1;
    char* PB = smem + X_PB + p * PB_SIZE;
    float* WARG = (float*)(smem + X_ARG); float* LW = WARG + 2048;
    float* C3 = (float*)(smem + X_C3) + p * 128; float* SEGT = (float*)(smem + X_SEG); float* CT = (float*)(PB + PB_CT);
    if (do_pre) {
      const bf16_t* pr = P.P + r * LDP; const bf16_t* pq = first ? P.P + (size_t)TT * LDP : pr - LDP;
      Lw = *(const u32x2*)(pr + RWL + c4); La = *(const u32x2*)(pr + RAL + c4); Lwq = *(const u32x2*)(pq + RWL + c4); Laq = *(const u32x2*)(pq + RAL + c4);
      Lr = *(const u32x2*)(pr + RR + hc); Lk = *(const u32x2*)(pr + RK + hc); Lv = *(const u32x2*)(pr + RV + hc); Lg = *(const u32x2*)(pr + RG + hc);
      Lrq = *(const u32x2*)(pq + RR + hc); Lkq = *(const u32x2*)(pq + RK + hc); Lvq = *(const u32x2*)(pq + RV + hc); Lgq = *(const u32x2*)(pq + RG + hc);
    }
    u32x2 post_val = {0u, 0u};
    if (do_post) {
      const int k = it - 1, pp = k & 1;
      const float* Y = (const float*)(smem + X_Y) + pp * 2048; const char* VT = smem + X_PB + pp * PB_SIZE + PB_VT;
      float y[4]; ld4f(Y + t * 64 + c4, y);
      const float mean = red16(y[0] + y[1] + y[2] + y[3]) * (1.f / 64.f); float q = 0.f;
#pragma unroll
      for (int e = 0; e < 4; ++e) { y[e] -= mean; q += y[e] * y[e]; }
      const float rs = rsqrtf(red16(q) * (1.f / 64.f) + 64e-5f);
      const float c3 = ((const float*)(smem + X_C3))[pp * 128 + t * 4 + 2]; float gg[4], lnw[4], lnb[4];
      ld4f(CONSTS + 576 + c4, lnw); ld4f(CONSTS + 640 + c4, lnb);
      unpack4(*(const u32x2*)(smem + X_GB + pp * 4096 + t * 128 + c4 * 2), gg);
#pragma unroll
      for (int e = 0; e < 4; ++e) { const float vv = bf2f(*(const bf16_t*)(VT + (c4 + e) * R40 + t * 2)); y[e] = (y[e] * rs * lnw[e] + lnb[e] + c3 * vv) * silu(gg[e]); }
      post_val = pack4(y);
    }
    float rr[4], kk[4], kka[4], km[4], lw[4];
    if (do_pre) {
      { float pw[4], pa[4], qw[4], qa[4], mw[4], ma[4];
        unpack4(Lw, pw); unpack4(La, pa); unpack4(Lwq, qw); unpack4(Laq, qa);
        ld4f(CONSTS + 704 + c4, mw); ld4f(CONSTS + 768 + c4, ma);
#pragma unroll
        for (int e = 0; e < 4; ++e) {
          pw[e] = tanh_(pw[e] + (qw[e] - pw[e]) * mw[e]); pa[e] = pa[e] + (qa[e] - pa[e]) * ma[e]; }
        *(u32x2*)(smem + X_LIN + t * ROWB + c4 * 2) = pack4(pw); *(u32x2*)(smem + X_LIN + 4608 + t * ROWB + c4 * 2) = pack4(pa); }
    }
    __syncthreads();
    if (do_pre && wid < 4) {
      const int mm = wid >> 1, ni = wid & 1;
      f32x16 d;
#pragma unroll
      for (int e = 0; e < 16; ++e) d[e] = 0.f;
#pragma unroll
      for (int ks = 0; ks < 4; ++ks) {
        const bf16x8 af = *(const bf16x8*)(smem + X_LIN + mm * 4608 + l31 * ROWB + ks * 32 + h * 16);
        const bf16x8 bf = *(const bf16x8*)(smem + (mm ? X_A2T : X_W2T) + (32 * ni + l31) * ROWB + ks * 32 + h * 16);
        d = MFMA(af, bf, d);
      }
      float* dst = WARG + mm * 2048;
#pragma unroll
      for (int e = 0; e < 16; ++e) dst[crow(e, h) * 64 + 32 * ni + l31] = d[e];
    }
    __syncthreads();
    if (do_pre) {
      float pr[4], pk[4], pv[4], pg[4], qr[4], qk[4], qv[4], qg[4];
      unpack4(Lr, pr); unpack4(Lk, pk); unpack4(Lv, pv); unpack4(Lg, pg); unpack4(Lrq, qr); unpack4(Lkq, qk); unpack4(Lvq, qv); unpack4(Lgq, qg);
      float mur[4], muk[4], muv[4], mug[4], w0v[4], a0v[4], kkw[4], kaw[4], rkw[4];
      ld4f(CONSTS + c4, mur); ld4f(CONSTS + 64 + c4, muk); ld4f(CONSTS + 128 + c4, muv); ld4f(CONSTS + 192 + c4, mug);
      ld4f(CONSTS + 256 + c4, w0v); ld4f(CONSTS + 320 + c4, a0v); ld4f(CONSTS + 384 + c4, kkw); ld4f(CONSTS + 448 + c4, kaw); ld4f(CONSTS + 512 + c4, rkw);
      float ssq = 0.f, s3 = 0.f; float gg[4];
#pragma unroll
      for (int e = 0; e < 4; ++e) {
        rr[e] = pr[e] + (qr[e] - pr[e]) * mur[e];
        const float kb = pk[e] + (qk[e] - pk[e]) * muk[e];
        const float vv = pv[e] + (qv[e] - pv[e]) * muv[e];
        gg[e] = pg[e] + (qg[e] - pg[e]) * mug[e];
        const float wa = WARG[t * 64 + c4 + e] + w0v[e];
        lw[e] = -0.606531f * sigm(wa);
        const float a = sigm(LW[t * 64 + c4 + e] + a0v[e]);
        kk[e] = kb * kkw[e]; ssq += kk[e] * kk[e];
        km[e] = kb * (1.f + (a - 1.f) * kaw[e]);
        kka[e] = a;
        s3 += rr[e] * km[e] * rkw[e];
        *(bf16_t*)(PB + PB_VT + (c4 + e) * R40 + t * 2) = f2bf(vv);
      }
      ssq = red16(ssq);
      const float inv = __builtin_amdgcn_rcpf(fmaxf(sqrtf(ssq), 1e-12f));
#pragma unroll
      for (int e = 0; e < 4; ++e) { kk[e] *= inv; kka[e] *= kk[e]; }
      s3 = red16(s3);
      if (cq == 0) C3[t * 4 + 2] = s3;
      { f32x4 lwv = {lw[0], lw[1], lw[2], lw[3]}; *(f32x4*)(LW + t * 64 + c4) = lwv; }
      *(u32x2*)(smem + X_GB + p * 4096 + t * 128 + c4 * 2) = pack4(gg);
    }
    asm volatile("s_waitcnt lgkmcnt(0)" ::: "memory");
    float run = 0.f; const int cc = tid & 63, ts = tid >> 6;
    if (do_pre) {
#pragma unroll
      for (int e = 0; e < 4; ++e) { run += LW[(4 * ts + e) * 64 + cc]; LW[(4 * ts + e) * 64 + cc] = run; }
      SEGT[ts * 64 + cc] = run;
    }
    __syncthreads();
    if (do_pre) {
      float ka[4], ro[4], al[4], be[4];
      f32x4 cumv = *(const f32x4*)(LW + t * 64 + c4);
      for (int s2_ = 0; s2_ < (t >> 2); ++s2_) cumv += *(const f32x4*)(SEGT + s2_ * 64 + c4);
      if (t == 31) *(f32x4*)(CT + c4) = cumv;
#pragma unroll
      for (int e = 0; e < 4; ++e) {
        const float cum = cumv[e], cprev = cum - lw[e];
        const float Ct = __expf(cum), Cp = __expf(cprev), iC = __expf(-cum);
        ka[e] = -kk[e] * Cp; ro[e] = rr[e] * Ct; al[e] = kka[e] * iC; be[e] = km[e] * iC;
        *(bf16_t*)(PB + PB_ALPT + (c4 + e) * R40 + t * 2) = f2bf(al[e]); *(bf16_t*)(PB + PB_BETT + (c4 + e) * R40 + t * 2) = f2bf(be[e]);
      }
      *(u32x2*)(PB + PB_KAP + t * ROWB + c4 * 2) = pack4(ka); *(u32x2*)(PB + PB_RHO + t * ROWB + c4 * 2) = pack4(ro);
      *(u32x2*)(smem + X_LIN + t * ROWB + c4 * 2) = pack4(al); *(u32x2*)(smem + X_LIN + 4608 + t * ROWB + c4 * 2) = pack4(be);
    }
    __syncthreads();
    if (do_post && !dry) *(u32x2*)(P.P + ((size_t)b * 2048 + (size_t)(it - 1) * 32 + t) * LDP + RG + hc) = post_val;
    if (do_pre && wid >= 4) {
      const int hw = wid - 4;
      const char* xa = PB + ((hw & 2) ? PB_RHO : PB_KAP); const char* ya = smem + X_LIN + ((hw & 1) ? 4608 : 0);
      f32x16 d;
#pragma unroll
      for (int e = 0; e < 16; ++e) d[e] = 0.f;
#pragma unroll
      for (int ks = 0; ks < 4; ++ks) {
        const bf16x8 yf = *(const bf16x8*)(ya + l31 * ROWB + ks * 32 + h * 16);
        const bf16x8 xf = *(const bf16x8*)(xa + l31 * ROWB + ks * 32 + h * 16);
        d = MFMA(yf, xf, d);
      }
      const bool incl = (hw & 2) != 0;
      int lt = l31; asm volatile("" : "+v"(lt));
#pragma unroll
      for (int e = 0; e < 16; ++e) { const int j = crow(e, h); d[e] = (incl ? (j <= lt) : (j < lt)) ? d[e] : 0.f; }
      if (hw != 0) {
        char* dst = PB + (hw == 1 ? PB_NB : (hw == 2 ? PB_MA : PB_MB));
#pragma unroll
        for (int g4 = 0; g4 < 4; ++g4) { u32x2 ov = {pk2(d[4 * g4], d[4 * g4 + 1]), pk2(d[4 * g4 + 2], d[4 * g4 + 3])};
          *(u32x2*)(dst + lt * R40 + (8 * g4 + 4 * h) * 2) = ov; }
      } else {
        char* Qrow = smem + X_TS;
        __builtin_amdgcn_s_setprio(3);
        f32x16 pa = d;
#pragma unroll
        for (int e = 0; e < 16; ++e) if (crow(e, h) == lt) pa[e] += 1.f;
#pragma unroll
        for (int e = 0; e < 16; ++e) *(bf16_t*)(Qrow + crow(e, h) * R40 + lt * 2) = f2bf(d[e]);
#pragma unroll 1
        for (int i = 0; i < 4; ++i) {
          asm volatile("s_waitcnt lgkmcnt(0)" ::: "memory");
          f32x16 qn;
#pragma unroll
          for (int e = 0; e < 16; ++e) qn[e] = 0.f;
          const bf16x8 qa0 = ld_perm(Qrow + lt * R40 + (4 * h) * 2), qa1 = ld_perm(Qrow + lt * R40 + (16 + 4 * h) * 2);
          qn = MFMA(qa0, pack_acc(d, 0), qn); qn = MFMA(qa1, pack_acc(d, 1), qn);
          d = qn;
#pragma unroll
          for (int e = 0; e < 16; ++e) *(bf16_t*)(Qrow + crow(e, h) * R40 + lt * 2) = f2bf(d[e]);
          asm volatile("s_waitcnt lgkmcnt(0)" ::: "memory");
          const bf16x8 qb0 = ld_perm(Qrow + lt * R40 + (4 * h) * 2), qb1 = ld_perm(Qrow + lt * R40 + (16 + 4 * h) * 2);
          const bf16x8 pp0 = pack_acc(pa, 0), pp1 = pack_acc(pa, 1);
          pa = MFMA(qb0, pp0, pa); pa = MFMA(qb1, pp1, pa);
        }
#pragma unroll
        for (int g4 = 0; g4 < 4; ++g4) { u32x2 ov = {pk2(pa[4 * g4], pa[4 * g4 + 1]), pk2(pa[4 * g4 + 2], pa[4 * g4 + 3])};
          *(u32x2*)(PB + PB_TT + lt * R40 + (8 * g4 + 4 * h) * 2) = ov; }
        __builtin_amdgcn_s_setprio(0);
      }
    } else if (do_cons && wid < 2) {
      const int pc = it & 1; const char* PC = smem + X_PB + pc * PB_SIZE; const int vrow = 32 * wid + l31;
      bf16x8 sp[2][2];
#pragma unroll
      for (int kb = 0; kb < 2; ++kb)
#pragma unroll
        for (int s = 0; s < 2; ++s) sp[kb][s] = pack_acc(St[kb], s);
      bf16x8 vf[2];
#pragma unroll
      for (int s = 0; s < 2; ++s) vf[s] = *(const bf16x8*)(PC + PB_VT + vrow * R40 + (16 * s + 8 * h) * 2);
      f32x16 X, Y;
#pragma unroll
      for (int e = 0; e < 16; ++e) { X[e] = 0.f; Y[e] = 0.f; }
#pragma unroll
      for (int kb = 0; kb < 2; ++kb)
#pragma unroll
        for (int s = 0; s < 2; ++s) {
          X = MFMA(ld_perm(PC + PB_KAP + l31 * ROWB + (32 * kb + 16 * s + 4 * h) * 2), sp[kb][s], X);
          Y = MFMA(ld_perm(PC + PB_RHO + l31 * ROWB + (32 * kb + 16 * s + 4 * h) * 2), sp[kb][s], Y);
        }
#pragma unroll
      for (int s = 0; s < 2; ++s) {
        X = MFMA(*(const bf16x8*)(PC + PB_NB + l31 * R40 + (16 * s + 8 * h) * 2), vf[s], X);
        Y = MFMA(*(const bf16x8*)(PC + PB_MB + l31 * R40 + (16 * s + 8 * h) * 2), vf[s], Y);
      }
      f32x16 U;
#pragma unroll
      for (int e = 0; e < 16; ++e) U[e] = 0.f;
#pragma unroll
      for (int s = 0; s < 2; ++s) U = MFMA(ld_perm(PC + PB_TT + l31 * R40 + (16 * s + 4 * h) * 2), pack_acc(X, s), U);
      bf16x8 up[2];
#pragma unroll
      for (int s = 0; s < 2; ++s) up[s] = pack_acc(U, s);
#pragma unroll
      for (int s = 0; s < 2; ++s) Y = MFMA(ld_perm(PC + PB_MA + l31 * R40 + (16 * s + 4 * h) * 2), up[s], Y);
      { float* Yo = (float*)(smem + X_Y) + pc * 2048;
#pragma unroll
        for (int e = 0; e < 16; ++e) Yo[crow(e, h) * 64 + vrow] = Y[e]; }
      const float* CTc = (const float*)(PC + PB_CT);
#pragma unroll
      for (int kb = 0; kb < 2; ++kb) {
#pragma unroll
        for (int s = 0; s < 2; ++s) {
          St[kb] = MFMA(ld_perm(PC + PB_ALPT + (32 * kb + l31) * R40 + (16 * s + 4 * h) * 2), up[s], St[kb]);
          St[kb] = MFMA(*(const bf16x8*)(PC + PB_BETT + (32 * kb + l31) * R40 + (16 * s + 8 * h) * 2), vf[s], St[kb]);
        }
#pragma unroll
        for (int g4 = 0; g4 < 4; ++g4) { const f32x4 ct = *(const f32x4*)(CTc + 32 * kb + 8 * g4 + 4 * h);
#pragma unroll
          for (int e = 0; e < 4; ++e) St[kb][4 * g4 + e] *= __expf(ct[e]); }
      }
    }
    __syncthreads();
  }
  if (wid < 2) {
#pragma unroll
    for (int kb = 0; kb < 2; ++kb)
#pragma unroll
      for (int g4 = 0; g4 < 4; ++g4) { f32x4 o = {St[kb][4 * g4], St[kb][4 * g4 + 1], St[kb][4 * g4 + 2], St[kb][4 * g4 + 3]};
        *(f32x4*)(P.out + O_RWKVP + ((size_t)(b * 16 + hd) * 64 + 32 * wid + l31) * 64 + 32 * kb + 8 * g4 + 4 * h) = o; }
  }
  __syncthreads();
}

__device__ void gla_sample_unit(const Params& P, char* smem, int sb, int hd, bool dry) {
  const int tid = tid_();
  float* AD = (float*)smem; float* Qs = AD + 128; float* Ks = Qs + 128; float* Vs = Ks + 128; float* OP = Vs + 256; float* RED = OP + 2048;
  const size_t r = (size_t)TP + sb;
  if (tid < 128) { const int dk = tid; float x = P.gla_b[hd * 128 + dk];
#pragma unroll
    for (int j = 0; j < 16; ++j) x += bf2f(P.P[r * LDP + GA + j]) * P.gla_w2[j * 512 + hd * 128 + dk];
    AD[dk] = __expf(logsig(x) * 0.0625f);
    Qs[dk] = bf2f(P.P[r * LDP + GQ + hd * 128 + dk]) * 0.08838834764831845f; Ks[dk] = bf2f(P.P[r * LDP + GK + hd * 128 + dk]); }
  else if (tid < 384) { const int dv = tid - 128; Vs[dv] = bf2f(P.P[r * LDP + GV + hd * 256 + dv]); }
  __syncthreads();
  { const int dv4 = (tid & 63) * 4, ds = tid >> 6; f32x4 oacc = {0.f, 0.f, 0.f, 0.f}; const f32x4 v4 = *(const f32x4*)(Vs + dv4);
    const size_t base = ((size_t)(sb * 4 + hd) * 128) * 256;
    f32x4 sin[16];
#pragma unroll
    for (int e = 0; e < 16; ++e) sin[e] = *(const f32x4*)(P.state_gla + base + (size_t)(16 * ds + e) * 256 + dv4);
#pragma unroll
    for (int e = 0; e < 16; ++e) { const int dk = 16 * ds + e;
      const f32x4 s4 = sin[e];
      const f32x4 sn = s4 * AD[dk] + v4 * Ks[dk];
      *(f32x4*)(P.out + O_GLAS + base + (size_t)dk * 256 + dv4) = sn;
      oacc += sn * Qs[dk]; }
    *(f32x4*)(OP + ds * 256 + dv4) = oacc; }
  __syncthreads();
  float ov = 0.f;
  if (tid < 256) { for (int s = 0; s < 8; ++s) ov += OP[s * 256 + tid]; const float q = red64(ov * ov); if ((tid & 63) == 0) RED[tid >> 6] = q; }
  __syncthreads();
  if (tid < 256) { const float rs = rsqrtf((RED[0] + RED[1] + RED[2] + RED[3]) * (1.f / 256.f) + 1e-5f);
    bf16_t* gp = P.P + r * LDP + GG + hd * 256 + tid;
    const bf16_t res = f2bf(ov * rs * P.gla_nw[tid] * silu(bf2f(*gp))); if (!dry) *gp = res; }
  __syncthreads();
}

__device__ void rwkv_sample_unit(const Params& P, char* smem, int sb, int half, bool dry) {
  const int tid = tid_(), lane = tid & 63, wid = tid >> 6;
  float* LWv = (float*)smem; float* LAv = LWv + 64; float* KK = LAv + 64; float* WW = KK + 512; float* KA = WW + 512; float* KM = KA + 512;
  float* RRv = KM + 512; float* VVv = RRv + 512; float* GBv = VVv + 512; float* Yv = GBv + 512; float* BON = Yv + 512;
  const size_t r = (size_t)TP + sb; const float* sh = P.state_shift + (size_t)sb * 4224;
  if (tid < 64) { const int j = tid;
    const float pw = bf2f(P.P[r * LDP + RWL + j]), pa = bf2f(P.P[r * LDP + RAL + j]);
    LWv[j] = tanh_(pw + (sh[4096 + j] - pw) * P.mu[4096 + j]); LAv[j] = pa + (sh[4160 + j] - pa) * P.mu[4160 + j]; }
  __syncthreads();
  { const int c = half * 512 + tid;
    float wa = P.w0[c], aa = P.a0[c];
#pragma unroll 32
    for (int j = 0; j < 64; ++j) { wa += LWv[j] * P.w2[j * 1024 + c]; aa += LAv[j] * P.a2[j * 1024 + c]; }
    const float pr = bf2f(P.P[r * LDP + RR + c]), pk = bf2f(P.P[r * LDP + RK + c]), pv = bf2f(P.P[r * LDP + RV + c]), pg = bf2f(P.P[r * LDP + RG + c]);
    const float rr = pr + (sh[c] - pr) * P.mu[c], kb = pk + (sh[1024 + c] - pk) * P.mu[1024 + c];
    const float vv = pv + (sh[2048 + c] - pv) * P.mu[2048 + c], gg = pg + (sh[3072 + c] - pg) * P.mu[3072 + c];
    const float w = __expf(-0.606531f * sigm(wa)), a = sigm(aa);
    float kk = kb * P.k_k[c]; const float nrm = sqrtf(red64(kk * kk)); kk = kk / fmaxf(nrm, 1e-12f);
    const float km = kb * (1.f + (a - 1.f) * P.k_a[c]);
    const float bon = red64(rr * km * P.r_k[c]);
    KK[tid] = -kk; WW[tid] = w; KA[tid] = kk * a; KM[tid] = km; RRv[tid] = rr; VVv[tid] = vv; GBv[tid] = gg; if (lane == 0) BON[wid] = bon; }
  __syncthreads();
  { const int row = tid >> 3, c8 = (tid & 7) * 8;
    float sall[8][8];
#pragma unroll
    for (int hh = 0; hh < 8; ++hh) ld8f(P.state_rwkv + ((size_t)(sb * 16 + half * 8 + hh) * 64 + row) * 64 + c8, sall[hh]);
#pragma unroll
    for (int hh = 0; hh < 8; ++hh) {
      const size_t base = ((size_t)(sb * 16 + half * 8 + hh) * 64 + row) * 64 + c8;
      float s[8]; float d = 0.f;
#pragma unroll
      for (int e = 0; e < 8; ++e) s[e] = sall[hh][e];
#pragma unroll
      for (int e = 0; e < 8; ++e) d += s[e] * KK[hh * 64 + c8 + e];
      const float sa = red8(d); const float vv = VVv[hh * 64 + row]; float y = 0.f;
#pragma unroll
      for (int e = 0; e < 8; ++e) { s[e] = s[e] * WW[hh * 64 + c8 + e] + sa * KA[hh * 64 + c8 + e] + vv * KM[hh * 64 + c8 + e]; y += s[e] * RRv[hh * 64 + c8 + e]; }
      f32x4 o0 = {s[0], s[1], s[2], s[3]}, o1 = {s[4], s[5], s[6], s[7]};
      *(f32x4*)(P.out + O_RWKVS + base) = o0; *(f32x4*)(P.out + O_RWKVS + base + 4) = o1;
      y = red8(y); if ((tid & 7) == 0) Yv[hh * 64 + row] = y;
    } }
  __syncthreads();
  { const int c = half * 512 + tid; const float y = Yv[tid]; const float mean = red64(y) * (1.f / 64.f); const float dd = y - mean;
    const float var = red64(dd * dd) * (1.f / 64.f);
    const float o = (dd * rsqrtf(var + 64e-5f) * P.lnx_w[c] + P.lnx_b[c] + BON[wid] * VVv[tid]) * silu(GBv[tid]);
    if (!dry) P.P[r * LDP + RG + c] = f2bf(o); }
  __syncthreads();
}

DI void blk_publish(unsigned* cnt) {
  asm volatile("s_waitcnt vmcnt(0)" ::: "memory");
  __syncthreads();
  if (threadIdx.x == 0) { __builtin_amdgcn_fence(__ATOMIC_RELEASE, "agent"); asm volatile("s_waitcnt vmcnt(0)" ::: "memory");
    __hip_atomic_fetch_add(cnt, 1u, __ATOMIC_RELAXED, __HIP_MEMORY_SCOPE_AGENT); }
}
DI void blk_wait(unsigned* cnt, unsigned target) {
  if (threadIdx.x == 0) { while (__hip_atomic_load(cnt, __ATOMIC_RELAXED, __HIP_MEMORY_SCOPE_AGENT) < target) __builtin_amdgcn_s_sleep(2);
    __builtin_amdgcn_fence(__ATOMIC_ACQUIRE, "agent"); asm volatile("s_waitcnt vmcnt(0)" ::: "memory"); }
  __syncthreads();
}
constexpr int C_PA = 384, C_SA = 448, C_PB = 512, C_SB = 576, C_BD = 640, C_QO = 704;
__device__ void phase2(const Params& P, char* smem, int roles, bool dry) {
  const int bid = blockIdx.x;
  if (bid < 128) { if (roles & 1) rwkv_prompt_unit(P, smem, bid >> 4, bid & 15, dry); if (!dry) blk_publish(P.ctr + C_BD + (bid >> 4)); }
  else if (bid < 160) { if (roles & 2) gla_prompt_unit(P, smem, (bid - 128) >> 2, (bid - 128) & 3, dry); if (!dry) blk_publish(P.ctr + C_BD + ((bid - 128) >> 2)); }
  const int tid = tid_();
  if (!dry) {
    const unsigned ngate = gridDim.x - 160;
    if (bid >= 160) {
      phase1_gates(P, smem, (int)ngate, bid - 160);
      asm volatile("s_waitcnt vmcnt(0)" ::: "memory");
      __syncthreads();
      if (tid == 0) { __builtin_amdgcn_fence(__ATOMIC_RELEASE, "agent"); __hip_atomic_fetch_add(P.ctr + 192, 1u, __ATOMIC_RELAXED, __HIP_MEMORY_SCOPE_AGENT); }
    }
    if (tid == 0) { while (__hip_atomic_load(P.ctr + 192, __ATOMIC_RELAXED, __HIP_MEMORY_SCOPE_AGENT) < ngate) __builtin_amdgcn_s_sleep(8); __builtin_amdgcn_fence(__ATOMIC_ACQUIRE, "agent"); }
    __syncthreads();
  }
  if (!(roles & 4)) return;
  unsigned* ctr = dry ? P.ctr + 128 : P.ctr;
  int* slot = (int*)(smem + SMEM_BYTES - 16);
  for (;;) {
    if (tid == 0) *slot = (int)atomicAdd(ctr, 1u);
    __syncthreads();
    const int u = *slot;
    __syncthreads();
    if (u >= 512 + 256) break;
    if (u < 512) gla_sample_unit(P, smem, u >> 2, u & 3, dry);
    else rwkv_sample_unit(P, smem, (u - 512) >> 1, (u - 512) & 1, dry);
  }
  if (!dry) blk_publish(P.ctr + C_QO);
}

DI float mini_gemm(const bf16_t* A, int lda, const bf16_t* Bt, int K, int r0, int c0, float* red) {
  const int tid = tid_(), lane = tid & 63, wid = tid >> 6, fr = lane & 15, fq = lane >> 4;
  f32x4 acc0 = {0.f, 0.f, 0.f, 0.f}, acc1 = {0.f, 0.f, 0.f, 0.f};
  const int kb = wid * 128;
  bf16x8 a0[4], a1[4], bb[4];
#pragma unroll
  for (int k = 0; k < 4; ++k) {
    a0[k] = *(const bf16x8*)(A + (size_t)(r0 + fr) * lda + kb + k * 32 + fq * 8); a1[k] = *(const bf16x8*)(A + (size_t)(r0 + 16 + fr) * lda + kb + k * 32 + fq * 8);
    bb[k] = *(const bf16x8*)(Bt + (size_t)(c0 + fr) * K + kb + k * 32 + fq * 8); }
#pragma unroll
  for (int k = 0; k < 4; ++k) {
    acc0 = __builtin_amdgcn_mfma_f32_16x16x32_bf16(a0[k], bb[k], acc0, 0, 0, 0);
    acc1 = __builtin_amdgcn_mfma_f32_16x16x32_bf16(a1[k], bb[k], acc1, 0, 0, 0);
  }
  __syncthreads();
#pragma unroll
  for (int j = 0; j < 4; ++j) { red[wid * 512 + (4 * fq + j) * 16 + fr] = acc0[j]; red[wid * 512 + (16 + 4 * fq + j) * 16 + fr] = acc1[j]; }
  __syncthreads();
  float v = 0.f;
#pragma unroll
  for (int w = 0; w < 8; ++w) v += red[w * 512 + tid];
  return v;
}

struct Epi3a {
  const Params* P;
  DI bool operator()(f32x4 (&acc)[2][2][4][2], const g8::Unit& u, int wr, int wc, int fr, int fq) const {
    const Params& Q = *P;
#pragma unroll
    for (int ai = 0; ai < 2; ++ai) {
      u32x4 gbv[4][2];
#pragma unroll
      for (int m = 0; m < 4; ++m)
#pragma unroll
        for (int bj = 0; bj < 2; ++bj) {
          const int row = u.pm * 256 + ai * 128 + wr * 64 + m * 16 + fr, col = u.pn * 256 + bj * 128 + wc * 32 + 8 * fq;
          gbv[m][bj] = *(const u32x4*)(Q.SG + (size_t)row * 2048 + 1024 + col); }
#pragma unroll
      for (int m = 0; m < 4; ++m) {
        const int row = u.pm * 256 + ai * 128 + wr * 64 + m * 16 + fr;
#pragma unroll
        for (int bj = 0; bj < 2; ++bj) {
          const int col = u.pn * 256 + bj * 128 + wc * 32 + 8 * fq;
          float gb[8]; unpack8(gbv[m][bj], gb);
          if (u.sub == 0) {
            float ga[8]; unpack8(*(const u32x4*)(Q.SG + (size_t)row * 2048 + col), ga);
#pragma unroll
            for (int j = 0; j < 4; ++j) { acc[ai][bj][m][0][j] *= ga[j] * __builtin_amdgcn_rcpf(gb[j]); acc[ai][bj][m][1][j] *= ga[4 + j] * __builtin_amdgcn_rcpf(gb[4 + j]); }
          } else {
            const f32x4 v0 = acc[ai][bj][m][0], v1 = acc[ai][bj][m][1];
            u32x4 o = {pk2(gb[0] * v0[0], gb[1] * v0[1]), pk2(gb[2] * v0[2], gb[3] * v0[3]), pk2(gb[4] * v1[0], gb[5] * v1[1]), pk2(gb[6] * v1[2], gb[7] * v1[3])};
            *(u32x4*)(Q.P + (size_t)row * LDP + col) = o;
          }
        }
      }
    }
    return u.sub == 0;
  }
};
__device__ void phase3a(const Params& P, char* smem) {
  g8::Job g; g.A0 = P.P + GG; g.A1 = P.P + RG; g.B0 = P.Wupg; g.B1 = P.Wupr; g.lda = LDP; g.K = 1024;
  g8::Order S; S.init(64, 4, (int)gridDim.x, (int)blockIdx.x, 2);
  Epi3a E; E.P = &P;
  g8::Unit u; const bool has = S.next(0, u);
  if (has) blk_wait(P.ctr + C_BD + (u.pm >> 3), 20u);
  g8::gemm_phase((G8_LAS unsigned char*)smem, g, S, E);
  if (has) blk_publish(P.ctr + C_PA + u.pm);
  if (blockIdx.x < 256) {
    blk_wait(P.ctr + C_QO, gridDim.x);
    const int r0 = TP + (blockIdx.x >> 6) * 32, c0 = (blockIdx.x & 63) * 16, tid = threadIdx.x;
    const float ua = mini_gemm(P.P + GG, LDP, P.Wupg, 1024, r0, c0, (float*)smem);
    const float ub = mini_gemm(P.P + RG, LDP, P.Wupr, 1024, r0, c0, (float*)smem);
    const int row = r0 + (tid >> 4), col = c0 + (tid & 15);
    const float m = bf2f(P.SG[(size_t)row * 2048 + col]) * ua + bf2f(P.SG[(size_t)row * 2048 + 1024 + col]) * ub;
    P.P[(size_t)row * LDP + col] = f2bf(m);
    blk_publish(P.ctr + C_SA);
  }
}
struct Epi3b {
  const Params* P;
  DI bool operator()(f32x4 (&acc)[2][2][4][2], const g8::Unit& u, int wr, int wc, int fr, int fq) const {
    const Params& Q = *P;
#pragma unroll
    for (int ai = 0; ai < 2; ++ai) {
      f32x4 xv[4][2][2];
#pragma unroll
      for (int m = 0; m < 4; ++m)
#pragma unroll
        for (int bj = 0; bj < 2; ++bj) {
          const int row = u.pm * 256 + ai * 128 + wr * 64 + m * 16 + fr, col = u.pn * 256 + bj * 128 + wc * 32 + 8 * fq;
          const float* xr = Q.x_prompt + (size_t)row * 1024 + col;
          xv[m][bj][0] = *(const f32x4*)xr; xv[m][bj][1] = *(const f32x4*)(xr + 4); }
#pragma unroll
      for (int m = 0; m < 4; ++m)
#pragma unroll
        for (int bj = 0; bj < 2; ++bj) {
          const int row = u.pm * 256 + ai * 128 + wr * 64 + m * 16 + fr, col = u.pn * 256 + bj * 128 + wc * 32 + 8 * fq;
          const f32x4 z0 = acc[ai][bj][m][0] + xv[m][bj][0] * 1.189207115002721f, z1 = acc[ai][bj][m][1] + xv[m][bj][1] * 1.189207115002721f;
          u32x4 o = {pk2(z0[0], z0[1]), pk2(z0[2], z0[3]), pk2(z1[0], z1[1]), pk2(z1[2], z1[3])};
          *(u32x4*)((bf16_t*)(Q.out + O_YP + (size_t)row * 1024) + col) = o; }
    }
    return false;
  }
};
DI void ln_row(const Params& P, int row, int lane) {
  float* yr = P.out + O_YP + (size_t)row * 1024;
  const u32x4 r0 = *(const u32x4*)((const bf16_t*)yr + lane * 8), r1 = *(const u32x4*)((const bf16_t*)yr + 512 + lane * 8);
  float v[16]; { float a[8], b[8]; unpack8(r0, a); unpack8(r1, b);
#pragma unroll
    for (int e = 0; e < 8; ++e) { v[e] = a[e]; v[8 + e] = b[e]; } }
  float s = 0.f;
#pragma unroll
  for (int e = 0; e < 16; ++e) s += v[e];
  const float mean = red64(s) * (1.f / 1024.f); float qq = 0.f;
#pragma unroll
  for (int e = 0; e < 16; ++e) { v[e] -= mean; qq += v[e] * v[e]; }
  const float rs = rsqrtf(red64(qq) * (1.f / 1024.f) + 1e-5f);
#pragma unroll
  for (int q = 0; q < 2; ++q)
#pragma unroll
    for (int hh = 0; hh < 2; ++hh) { const int col = q * 512 + lane * 8 + hh * 4;
      const f32x4 g = *(const f32x4*)(P.ln_g + col), bb = *(const f32x4*)(P.ln_b + col);
      f32x4 x = {v[q * 8 + hh * 4], v[q * 8 + hh * 4 + 1], v[q * 8 + hh * 4 + 2], v[q * 8 + hh * 4 + 3]};
      *(f32x4*)(yr + col) = x * rs * g + bb; }
}
__device__ void phase3bc(const Params& P, char* smem) {
  g8::Job g; g.A0 = P.P; g.A1 = P.P; g.B0 = P.Wout; g.B1 = P.Wout; g.lda = LDP; g.K = 1024;
  g8::Order S; S.init(64, 4, (int)gridDim.x, (int)blockIdx.x, 1);
  Epi3b E; E.P = &P;
  g8::Unit u; const bool has = S.next(0, u);
  if (has) blk_wait(P.ctr + C_PA + u.pm, 4u);
  g8::gemm_phase((G8_LAS unsigned char*)smem, g, S, E);
  if (has) blk_publish(P.ctr + C_PB + u.pm);
  if (blockIdx.x < 256) {
    blk_wait(P.ctr + C_SA, 256u);
    const int r0 = TP + (blockIdx.x >> 6) * 32, c0 = (blockIdx.x & 63) * 16, tid = threadIdx.x;
    const float v = mini_gemm(P.P, LDP, P.Wout, 1024, r0, c0, (float*)smem);
    const int row = r0 + (tid >> 4), col = c0 + (tid & 15);
    ((bf16_t*)(P.out + O_YP + (size_t)row * 1024))[col] = f2bf(v + 1.189207115002721f * P.x_sample[(size_t)(row - TP) * 1024 + col]);
    blk_publish(P.ctr + C_SB);
  }
  const int tid = tid_(), lane = tid & 63, wid = tid >> 6;
  if (has) {
    blk_wait(P.ctr + C_PB + u.pm, 4u);
    for (int i = 0; i < 8; ++i) ln_row(P, u.pm * 256 + u.pn * 64 + wid * 8 + i, lane);
  }
  if (blockIdx.x < 16) {
    blk_wait(P.ctr + C_SB, 256u);
    ln_row(P, TP + blockIdx.x * 8 + wid, lane);
  }
}
__device__ void phase3b(const Params& P, char* smem) { phase3bc(P, smem); }
__device__ void phase3c(const Params& P) {}

DI void grid_bar(unsigned* cnt, unsigned target) {
  asm volatile("s_waitcnt vmcnt(0) lgkmcnt(0)" ::: "memory");
  __syncthreads();
  if (threadIdx.x == 0) {
    __builtin_amdgcn_fence(__ATOMIC_RELEASE, "agent");
    asm volatile("s_waitcnt vmcnt(0)" ::: "memory");
    __hip_atomic_fetch_add(cnt, 1u, __ATOMIC_RELAXED, __HIP_MEMORY_SCOPE_AGENT);
    while (__hip_atomic_load(cnt, __ATOMIC_RELAXED, __HIP_MEMORY_SCOPE_AGENT) < target) __builtin_amdgcn_s_sleep(2);
    __builtin_amdgcn_fence(__ATOMIC_ACQUIRE, "agent");
    asm volatile("s_waitcnt vmcnt(0)" ::: "memory");
  }
  __syncthreads();
}

#if ONE_LAUNCH
__global__ void __launch_bounds__(NT) fwd_megakernel(Params P) {
  extern __shared__ __attribute__((aligned(16))) char smem[];
  cg::grid_group grid = cg::this_grid();
  const unsigned nb = gridDim.x;
  phase0(P, smem); grid.sync();
  phase1(P, smem); grid_bar(P.ctr + 64, nb);
#ifdef PROBE_ROLES
  phase2(P, smem, PROBE_ROLES, true); grid_bar(P.ctr + 64, 2 * nb);
  phase2(P, smem, 7, false); grid_bar(P.ctr + 64, 3 * nb);
  phase3a(P, smem); grid_bar(P.ctr + 64, 4 * nb);
  phase3b(P, smem); grid_bar(P.ctr + 64, 5 * nb);
  phase3c(P);
  return;
#endif
  phase2(P, smem, 7, false);
  phase3a(P, smem);
  phase3bc(P, smem);
}
#else
__global__ void __launch_bounds__(NT) k_phase0(Params P) { extern __shared__ __attribute__((aligned(16))) char smem[]; phase0(P, smem); }
__global__ void __launch_bounds__(NT) k_phase1(Params P) { extern __shared__ __attribute__((aligned(16))) char smem[]; phase1(P, smem); }
__global__ void __launch_bounds__(NT) k_phase2(Params P) { extern __shared__ __attribute__((aligned(16))) char smem[]; phase2(P, smem, 7, false); }
__global__ void __launch_bounds__(NT) k_phase3a(Params P) { extern __shared__ __attribute__((aligned(16))) char smem[]; phase3a(P, smem); }
__global__ void __launch_bounds__(NT) k_phase3b(Params P) { extern __shared__ __attribute__((aligned(16))) char smem[]; phase3b(P, smem); }
__global__ void __launch_bounds__(NT) k_phase3c(Params P) { phase3c(P); }
#endif

extern "C" void kernel_launch(void* const* d_in, const int* in_sizes, int n_in, void* d_out, int out_size, void* d_ws, size_t ws_size,
                              hipStream_t stream) {
  Params P{};
  const float* const* in = (const float* const*)d_in;
  P.x_prompt = in[0]; P.x_sample = in[1]; P.state_gla = in[2]; P.state_rwkv = in[3]; P.state_shift = in[4]; P.w_in = in[5];
  P.gla_w2 = in[6]; P.gla_b = in[7]; P.gla_nw = in[8]; P.mu = in[9]; P.w0 = in[10]; P.w2 = in[11]; P.a0 = in[12]; P.a2 = in[13];
  P.k_k = in[14]; P.k_a = in[15]; P.r_k = in[16]; P.lnx_w = in[17]; P.lnx_b = in[18]; P.w_upg = in[19]; P.w_upr = in[20]; P.w_out = in[21];
  P.ln_g = in[22]; P.ln_b = in[23];
  P.out = (float*)d_out;
  char* ws = (char*)d_ws;
  P.P = (bf16_t*)ws;
  const size_t psz = (size_t)(TT + 128) * LDP * 2;
  P.Wupg = (bf16_t*)(ws + psz); P.Wupr = P.Wupg + 1024 * 1024; P.Wout = P.Wupr + 1024 * 1024;
  P.ctr = (unsigned*)(P.Wout + 1024 * 1024);
  P.xb = (bf16_t*)((float*)d_out + O_GLAS);
  P.Wtin = P.xb + (size_t)(TT + 128) * 1024;
  P.SG = (bf16_t*)d_out;
#if ONE_LAUNCH
  static int grid_blocks = 0;
  if (!grid_blocks) {
    hipFuncSetAttribute((const void*)fwd_megakernel, hipFuncAttributeMaxDynamicSharedMemorySize, SMEM_BYTES);
    int dev = 0, cus = 0, per_cu = 0;
    hipGetDevice(&dev);
    hipDeviceGetAttribute(&cus, hipDeviceAttributeMultiprocessorCount, dev);
    hipOccupancyMaxActiveBlocksPerMultiprocessor(&per_cu, fwd_megakernel, NT, SMEM_BYTES);
    if (per_cu < 1) per_cu = 1;
    grid_blocks = cus;
    if (grid_blocks < 192) grid_blocks = 192;
  }
  void* args[] = {&P};
  hipError_t e = hipLaunchCooperativeKernel((const void*)fwd_megakernel, dim3(grid_blocks), dim3(NT), args, SMEM_BYTES, stream);
  if (e != hipSuccess) fprintf(stderr, "cooperative launch failed: %s (grid %d)\n", hipGetErrorString(e), grid_blocks);
#else
  static bool init = false;
  if (!init) { init = true;
    hipFuncSetAttribute((const void*)k_phase0, hipFuncAttributeMaxDynamicSharedMemorySize, SMEM_BYTES);
    hipFuncSetAttribute((const void*)k_phase1, hipFuncAttributeMaxDynamicSharedMemorySize, SMEM_BYTES);
    hipFuncSetAttribute((const void*)k_phase2, hipFuncAttributeMaxDynamicSharedMemorySize, SMEM_BYTES);
    hipFuncSetAttribute((const void*)k_phase3a, hipFuncAttributeMaxDynamicSharedMemorySize, SMEM_BYTES);
    hipFuncSetAttribute((const void*)k_phase3b, hipFuncAttributeMaxDynamicSharedMemorySize, SMEM_BYTES);
  }
  k_phase0<<<256, NT, SMEM_BYTES, stream>>>(P);
  k_phase1<<<256, NT, SMEM_BYTES, stream>>>(P);
  k_phase2<<<256, NT, SMEM_BYTES, stream>>>(P);
  k_phase3a<<<256, NT, SMEM_BYTES, stream>>>(P);
  k_phase3b<<<256, NT, SMEM_BYTES, stream>>>(P);
  k_phase3c<<<256, NT, 0, stream>>>(P);
#endif
}
```

```cpp
#include <hip/hip_runtime.h>
#include <hip/hip_cooperative_groups.h>
#include <cstdio>
namespace cg = cooperative_groups;

#ifndef ONE_LAUNCH
#define ONE_LAUNCH 1
#endif

typedef unsigned short bf16_t;
typedef short bf16x8 __attribute__((ext_vector_type(8)));
typedef float f32x16 __attribute__((ext_vector_type(16)));
typedef float f32x4 __attribute__((ext_vector_type(4)));
typedef float f32x2 __attribute__((ext_vector_type(2)));
typedef unsigned u32x4 __attribute__((ext_vector_type(4)));
typedef unsigned u32x2 __attribute__((ext_vector_type(2)));
#define DI __device__ __forceinline__
#define MFMA(a, b, c) __builtin_amdgcn_mfma_f32_32x32x16_bf16((a), (b), (c), 0, 0, 0)

constexpr int NT = 512;
constexpr int SMEM_BYTES = 157696;
constexpr int TP = 16384, TT = 16512;
constexpr int LDP = 7424;
constexpr int GQ = 0, GK = 512, GV = 1024, GG = 2048, GA = 3072;
constexpr int RW = 3200;
constexpr int RR = RW, RK = RW + 1024, RV = RW + 2048, RG = RW + 3072, RWL = RW + 4096, RAL = RW + 4160;
constexpr int GATE = 7424;
constexpr int NTILE_N1 = 37, NTILE_M = 129;
constexpr size_t O_YP = 0, O_GLAP = 16908288, O_RWKVP = 17956864, O_SHP = 18481152, O_GLAS = 18514944,
                 O_RWKVS = 35292160, O_SHS = 43680768;

struct Params {
  const float *x_prompt, *x_sample, *state_gla, *state_rwkv, *state_shift, *w_in, *gla_w2, *gla_b, *gla_nw, *mu,
      *w0, *w2, *a0, *a2, *k_k, *k_a, *r_k, *lnx_w, *lnx_b, *w_upg, *w_upr, *w_out, *ln_g, *ln_b;
  float* out;
  bf16_t *P, *Wupg, *Wupr, *Wout, *xb, *Wtin, *SG;
  unsigned* ctr;
};

DI int tid_() { int t = threadIdx.x; asm volatile("" : "+v"(t)); return t; }
DI float bf2f(bf16_t u) { return __uint_as_float((unsigned)u << 16); }
DI float bflo(unsigned u) { return __uint_as_float(u << 16); }
DI float bfhi(unsigned u) { return __uint_as_float(u & 0xffff0000u); }
typedef __bf16 bf16x2_t __attribute__((ext_vector_type(2)));
DI unsigned pk2(float lo, float hi) { f32x2 v = {lo, hi}; return __builtin_bit_cast(unsigned, __builtin_convertvector(v, bf16x2_t)); }
DI bf16_t f2bf(float x) { return (bf16_t)(pk2(x, x) & 0xffffu); }
DI float sigm(float x) { return __builtin_amdgcn_rcpf(1.f + __expf(-x)); }
DI float silu(float x) { return x * __builtin_amdgcn_rcpf(1.f + __expf(-x)); }
DI float logsig(float x) { return fminf(x, 0.f) - __logf(1.f + __expf(-fabsf(x))); }
DI float tanh_(float x) { float e = __expf(2.f * x); return 1.f - 2.f * __builtin_amdgcn_rcpf(e + 1.f); }
DI void unpack8(u32x4 v, float (&f)[8]) {
  f[0] = bflo(v[0]); f[1] = bfhi(v[0]); f[2] = bflo(v[1]); f[3] = bfhi(v[1]);
  f[4] = bflo(v[2]); f[5] = bfhi(v[2]); f[6] = bflo(v[3]); f[7] = bfhi(v[3]);
}
DI u32x4 pack8(const float (&f)[8]) { u32x4 o = {pk2(f[0], f[1]), pk2(f[2], f[3]), pk2(f[4], f[5]), pk2(f[6], f[7])}; return o; }
DI void ld8f(const float* p, float (&f)[8]) {
  f32x4 a = *(const f32x4*)p, b = *(const f32x4*)(p + 4);
  f[0] = a[0]; f[1] = a[1]; f[2] = a[2]; f[3] = a[3]; f[4] = b[0]; f[5] = b[1]; f[6] = b[2]; f[7] = b[3];
}
DI float red8(float x) {
  x += __builtin_bit_cast(float, __builtin_amdgcn_update_dpp(0, __builtin_bit_cast(int, x), 0xB1, 0xF, 0xF, true));
  x += __builtin_bit_cast(float, __builtin_amdgcn_update_dpp(0, __builtin_bit_cast(int, x), 0x4E, 0xF, 0xF, true));
  x += __builtin_bit_cast(float, __builtin_amdgcn_update_dpp(0, __builtin_bit_cast(int, x), 0x141, 0xF, 0xF, true));
  return x;
}
DI float red64(float x) {
  for (int o = 32; o > 0; o >>= 1) x += __shfl_xor(x, o);
  return x;
}
DI int crow(int reg, int h) { return (reg & 3) + 8 * (reg >> 2) + 4 * h; }
DI bf16x8 pack_acc(const f32x16& x, int s) {
  u32x4 p = {pk2(x[8 * s + 0], x[8 * s + 1]), pk2(x[8 * s + 2], x[8 * s + 3]), pk2(x[8 * s + 4], x[8 * s + 5]), pk2(x[8 * s + 6], x[8 * s + 7])};
  return __builtin_bit_cast(bf16x8, p);
}

__device__ void phase0(const Params& P, char* smem) {
  const int tid = tid_(), nb = gridDim.x, bid = blockIdx.x;
  if (bid == 0) for (int i = tid; i < 1024; i += NT) P.ctr[i] = 0u;
  { const int stride = nb * NT; int i = bid * NT + tid;
    for (; i + 3 * stride < TT * 128; i += 4 * stride) {
      float f[4][8];
#pragma unroll
      for (int u = 0; u < 4; ++u) { const int ii = i + u * stride, row = ii >> 7, c8 = (ii & 127) * 8;
        ld8f(row < TP ? P.x_prompt + (size_t)row * 1024 + c8 : P.x_sample + (size_t)(row - TP) * 1024 + c8, f[u]); }
#pragma unroll
      for (int u = 0; u < 4; ++u) { const int ii = i + u * stride, row = ii >> 7, c8 = (ii & 127) * 8; *(u32x4*)(P.xb + (size_t)row * 1024 + c8) = pack8(f[u]); }
    }
    for (; i < TT * 128; i += stride) { const int row = i >> 7, c8 = (i & 127) * 8; float f[8];
      ld8f(row < TP ? P.x_prompt + (size_t)row * 1024 + c8 : P.x_sample + (size_t)(row - TP) * 1024 + c8, f);
      *(u32x4*)(P.xb + (size_t)row * 1024 + c8) = pack8(f); } }
  for (int i = bid * NT + tid; i < 128 * 128; i += nb * NT) { u32x4 z = {0u, 0u, 0u, 0u}; *(u32x4*)(P.xb + (size_t)TT * 1024 + (size_t)i * 8) = z; }
  float* tile = (float*)smem;
  const int njobs = 16 * 148 + 3 * 256;
  const int kk0 = tid >> 4, nn = (tid & 15) * 4;
  f32x4 v0, v1;
  auto job_load = [&](int j) {
    const float* src; int ldsrc, k0, n0; bool isin;
    if (j < 16 * 148) { isin = true; src = P.w_in; ldsrc = 9360; k0 = (j & 15) * 64; n0 = (j >> 4) * 64; }
    else { int jj = j - 16 * 148; const int w = jj >> 8; jj &= 255; isin = false; ldsrc = 1024; src = w == 0 ? P.w_upg : (w == 1 ? P.w_upr : P.w_out); k0 = (jj & 15) * 64; n0 = (jj >> 4) * 64; }
    const int np = n0 + nn; int n = np;
    if (isin) n = np < 3088 ? np : (np < 3200 ? -1 : np - 112);
    v0 = (f32x4){0.f, 0.f, 0.f, 0.f}; v1 = v0;
    if (n >= 0) { v0 = *(const f32x4*)(src + (size_t)(k0 + kk0) * ldsrc + n); v1 = *(const f32x4*)(src + (size_t)(k0 + kk0 + 32) * ldsrc + n); }
  };
  if (bid < njobs) job_load(bid);
  for (int j = bid; j < njobs; j += nb) {
    bf16_t* dst; int k0, n0;
    if (j < 16 * 148) { dst = P.Wtin; k0 = (j & 15) * 64; n0 = (j >> 4) * 64; }
    else { int jj = j - 16 * 148; const int w = jj >> 8; jj &= 255; dst = w == 0 ? P.Wupg : (w == 1 ? P.Wupr : P.Wout); k0 = (jj & 15) * 64; n0 = (jj >> 4) * 64; }
    tile[kk0 * 65 + nn] = v0[0]; tile[kk0 * 65 + nn + 1] = v0[1]; tile[kk0 * 65 + nn + 2] = v0[2]; tile[kk0 * 65 + nn + 3] = v0[3];
    tile[(kk0 + 32) * 65 + nn] = v1[0]; tile[(kk0 + 32) * 65 + nn + 1] = v1[1]; tile[(kk0 + 32) * 65 + nn + 2] = v1[2]; tile[(kk0 + 32) * 65 + nn + 3] = v1[3];
    if (j + nb < njobs) job_load(j + nb);
    __syncthreads();
    { const int n2 = tid >> 3, ks = (tid & 7) * 8; float f[8];
#pragma unroll
      for (int e = 0; e < 8; ++e) f[e] = tile[(ks + e) * 65 + n2];
      *(u32x4*)(dst + (size_t)(n0 + n2) * 1024 + k0 + ks) = pack8(f); }
    __syncthreads();
  }
}

constexpr int ROWB = 144;
namespace g8 {
#define G8_LAS __attribute__((address_space(3)))
constexpr int BM = 256, BK = 64, HALF = 128, HTB = HALF * BK * 2, STAGE_BYTES = 8 * HTB, NXCD = 8, WGM = 8;
DI int lds_byte(int r, int c) { const int st = (r >> 4) * 2 + (c >> 5), rr = r & 15, cc = c & 31, ob = rr * 64 + cc * 2; return st * 1024 + (ob ^ (((ob >> 9) & 1) << 5)); }
DI void stage_rc(int b, int& R, int& C) { const int st = b / 1024, sb = b % 1024, swz = sb ^ (((sb >> 9) & 1) << 5); R = (st >> 1) * 16 + swz / 64; C = (st & 1) * 32 + (swz % 64) / 2; }
DI int perm32(int rho) { const int n = rho >> 4, i = rho & 15; return 8 * (i >> 2) + 4 * n + (i & 3); }
struct Unit { int pm, pn, sub; };
struct Job { const bf16_t* A0; const bf16_t* A1; const bf16_t* B0; const bf16_t* B1; int lda, K; };
struct Order {
  int nM, nN, nwg, G, c, nsub;
  DI void init(int nM_, int nN_, int G_, int c_, int nsub_) { nM = nM_; nN = nN_; nwg = nM * nN; G = G_; c = c_; nsub = nsub_; }
  DI bool next(int i, Unit& u) const {
    const int ti = nsub == 2 ? (i >> 1) : i; u.sub = nsub == 2 ? (i & 1) : 0;
    const long L = (long)ti * G + c; if (L >= nwg) return false;
    int wgid = (int)L; { const int q = nwg / NXCD, r = nwg % NXCD, xcd = wgid % NXCD, off = wgid / NXCD; wgid = (xcd < r ? xcd * (q + 1) : r * (q + 1) + (xcd - r) * q) + off; }
    const int nig = WGM * nN, gid = wgid / nig, fm = gid * WGM, gsz = (nM - fm) < WGM ? (nM - fm) : WGM;
    u.pm = fm + ((wgid % nig) % gsz); u.pn = (wgid % nig) / gsz; return true;
  }
};
template <class Epi>
DI void gemm_phase(G8_LAS unsigned char* lds, const Job g, const Order& S, Epi& E) {
  const int tid = tid_(), wid = __builtin_amdgcn_readfirstlane(tid >> 6), lane = tid & 63, wr = wid >> 2, wc = wid & 3, fr = lane & 15, fq = lane >> 4;
  const int K = g.K, nt = K / BK;
  unsigned voffA[2], voffB[2];
#pragma unroll
  for (int i = 0; i < 2; ++i) { int R, C; stage_rc(tid * 16 + i * 8192, R, C); const int Rb = (R & ~31) + perm32(R & 31);
    voffA[i] = (unsigned)(R * g.lda + C) * 2u; voffB[i] = (unsigned)(Rb * K + C) * 2u; }
  const size_t kstep = (size_t)(BK * 2);
  const size_t hstepA = (size_t)HALF * g.lda * 2, hstepB = (size_t)HALF * K * 2;
  const size_t tstepA = 2 * hstepA, tstepB = 2 * hstepB;
  const unsigned ldsw = (unsigned)wid * 1024u;
  const int aoff = lds_byte(wr * 64 + fr, fq * 8), boff = lds_byte(wc * 32 + fr, fq * 8);
#define G8_SA(b, h) (((b) * 2 + (h)) * HTB)
#define G8_SB(b, h) ((4 + (b) * 2 + (h)) * HTB)
#define G8_STAGE(bufoff, gbase, voff) do { _Pragma("unroll") for (int _i = 0; _i < 2; ++_i) \
    __builtin_amdgcn_global_load_lds((const unsigned*)((const char*)(gbase) + (voff)[_i]), (G8_LAS unsigned*)(lds + (bufoff) + ldsw + _i * 8192), 16, 0, 0); } while (0)
#define G8_LDA(dst, b, h) do { _Pragma("unroll") for (int m = 0; m < 4; ++m) _Pragma("unroll") for (int k = 0; k < 2; ++k) dst[m][k] = *(const G8_LAS bf16x8*)(lds + G8_SA(b, h) + aoff + m * 2048 + k * 1024); } while (0)
#define G8_LDB(dst, b, h) do { _Pragma("unroll") for (int n = 0; n < 2; ++n) _Pragma("unroll") for (int k = 0; k < 2; ++k) dst[n][k] = *(const G8_LAS bf16x8*)(lds + G8_SB(b, h) + boff + n * 2048 + k * 1024); } while (0)
#define G8_MMA(ai, bj, At, Bt) do { __builtin_amdgcn_s_setprio(1); _Pragma("unroll") for (int m = 0; m < 4; ++m) _Pragma("unroll") for (int n = 0; n < 2; ++n) _Pragma("unroll") for (int k = 0; k < 2; ++k) \
    acc[ai][bj][m][n] = __builtin_amdgcn_mfma_f32_16x16x32_bf16(Bt[n][k], At[m][k], acc[ai][bj][m][n], 0, 0, 0); __builtin_amdgcn_s_setprio(0); } while (0)
#define G8_WAIT_V(n) asm volatile("s_waitcnt vmcnt(" #n ")" ::: "memory")
#define G8_WAIT_L(n) asm volatile("s_waitcnt lgkmcnt(" #n ")" ::: "memory")
#define G8_BAR __builtin_amdgcn_s_barrier()
#define G8_SCHED __builtin_amdgcn_sched_barrier(0)
  Unit cur, nxt; int ui = 0;
  if (!S.next(0, cur)) return;
  f32x4 acc[2][2][4][2];
#pragma unroll
  for (int a = 0; a < 2; ++a)
#pragma unroll
    for (int b = 0; b < 2; ++b)
#pragma unroll
      for (int m = 0; m < 4; ++m)
#pragma unroll
        for (int n = 0; n < 2; ++n) acc[a][b][m][n] = (f32x4){0.f, 0.f, 0.f, 0.f};
  bf16x8 At[4][2], B0[2][2], B1[2][2];
  const char* cA = (const char*)(cur.sub ? g.A1 : g.A0) + (size_t)cur.pm * tstepA; const char* cB = (const char*)(cur.sub ? g.B1 : g.B0) + (size_t)cur.pn * tstepB;
  G8_STAGE(G8_SB(0, 0), cB, voffB); G8_STAGE(G8_SA(0, 0), cA, voffA); G8_STAGE(G8_SB(0, 1), cB + hstepB, voffB); G8_STAGE(G8_SA(0, 1), cA + hstepA, voffA);
  if (wr == 1) G8_BAR;
  G8_WAIT_V(4); G8_BAR;
  G8_STAGE(G8_SB(1, 0), cB + kstep, voffB); G8_STAGE(G8_SA(1, 0), cA + kstep, voffA); G8_STAGE(G8_SB(1, 1), cB + hstepB + kstep, voffB);
  G8_WAIT_V(6); G8_BAR;
  for (;;) {
    const bool has_next = S.next(ui + 1, nxt);
    const char* nA = has_next ? (const char*)(nxt.sub ? g.A1 : g.A0) + (size_t)nxt.pm * tstepA : cA;
    const char* nB = has_next ? (const char*)(nxt.sub ? g.B1 : g.B0) + (size_t)nxt.pn * tstepB : cB;
    for (int t = 0; t < nt; t += 2) {
      const bool last = (t == nt - 2);
      const char* a1 = cA + (size_t)(t + 1) * kstep;
      const char* a2 = last ? nA : cA + (size_t)(t + 2) * kstep; const char* b2 = last ? nB : cB + (size_t)(t + 2) * kstep;
      const char* a3 = a2 + kstep; const char* b3 = b2 + kstep;
      G8_LDB(B0, 0, 0); G8_SCHED; G8_LDA(At, 0, 0); G8_STAGE(G8_SA(1, 1), a1 + hstepA, voffA);
      G8_WAIT_L(8); G8_BAR; G8_WAIT_L(0); G8_MMA(0, 0, At, B0); G8_BAR; G8_SCHED;
      G8_LDB(B1, 0, 1); G8_STAGE(G8_SB(0, 0), b2, voffB);
      G8_BAR; G8_WAIT_L(0); G8_MMA(0, 1, At, B1); G8_BAR;
      G8_LDA(At, 0, 1); G8_STAGE(G8_SA(0, 0), a2, voffA);
      G8_BAR; G8_WAIT_L(0); G8_MMA(1, 0, At, B0); G8_BAR; G8_SCHED;
      G8_STAGE(G8_SB(0, 1), b2 + hstepB, voffB);
      G8_WAIT_V(6); G8_BAR; G8_MMA(1, 1, At, B1); G8_BAR;
      G8_LDB(B0, 1, 0); G8_SCHED; G8_LDA(At, 1, 0); G8_STAGE(G8_SA(0, 1), a2 + hstepA, voffA);
      G8_WAIT_L(8); G8_BAR; G8_WAIT_L(0); G8_MMA(0, 0, At, B0); G8_BAR; G8_SCHED;
      G8_LDB(B1, 1, 1); G8_STAGE(G8_SB(1, 0), b3, voffB);
      G8_BAR; G8_WAIT_L(0); G8_MMA(0, 1, At, B1); G8_BAR;
      G8_LDA(At, 1, 1); G8_STAGE(G8_SA(1, 0), a3, voffA);
      G8_BAR; G8_WAIT_L(0); G8_MMA(1, 0, At, B0); G8_BAR; G8_SCHED;
      G8_STAGE(G8_SB(1, 1), b3 + hstepB, voffB);
      G8_WAIT_V(6); G8_BAR; G8_MMA(1, 1, At, B1); G8_BAR;
    }
    const bool keep = E(acc, cur, wr, wc, fr, fq);
    if (!has_next) break;
    if (!keep) {
#pragma unroll
      for (int a = 0; a < 2; ++a)
#pragma unroll
        for (int b = 0; b < 2; ++b)
#pragma unroll
          for (int m = 0; m < 4; ++m)
#pragma unroll
            for (int n = 0; n < 2; ++n) acc[a][b][m][n] = (f32x4){0.f, 0.f, 0.f, 0.f};
    }
    cur = nxt; cA = nA; cB = nB; ++ui;
  }
  G8_WAIT_V(0);
  if (wr == 0) G8_BAR;
  G8_BAR;
#undef G8_SA
#undef G8_SB
#undef G8_STAGE
#undef G8_LDA
#undef G8_LDB
#undef G8_MMA
#undef G8_WAIT_V
#undef G8_WAIT_L
#undef G8_BAR
#undef G8_SCHED
}
}

struct Epi1 {
  const Params* P; int pn_off;
  DI bool operator()(f32x4 (&acc)[2][2][4][2], const g8::Unit& u0, int wr, int wc, int fr, int fq) const {
    const Params& Q = *P; g8::Unit u = u0; u.pn += pn_off;
#pragma unroll
    for (int ai = 0; ai < 2; ++ai)
#pragma unroll
      for (int m = 0; m < 4; ++m) {
        const int row = u.pm * 256 + ai * 128 + wr * 64 + m * 16 + fr;
#pragma unroll
        for (int bj = 0; bj < 2; ++bj) {
          const int col = u.pn * 256 + bj * 128 + wc * 32 + 8 * fq;
          const f32x4 v0 = acc[ai][bj][m][0], v1 = acc[ai][bj][m][1];
          if (col < GATE) {
            u32x4 o = {pk2(v0[0], v0[1]), pk2(v0[2], v0[3]), pk2(v1[0], v1[1]), pk2(v1[2], v1[3])};
            *(u32x4*)(Q.P + (size_t)row * LDP + col) = o;
            if (col >= RW && row < TT) {
              float* d = nullptr;
              if (row >= TP) d = Q.out + O_SHS + (size_t)(row - TP) * 4224 + (col - RW);
              else if ((row & 2047) == 2047) d = Q.out + O_SHP + (size_t)(row >> 11) * 4224 + (col - RW);
              if (d) { *(f32x4*)d = v0; *(f32x4*)(d + 4) = v1; }
            }
          } else if (row < TT) {
            u32x4 o = {pk2(sigm(v0[0]), sigm(v0[1])), pk2(sigm(v0[2]), sigm(v0[3])), pk2(sigm(v1[0]), sigm(v1[1])), pk2(sigm(v1[2]), sigm(v1[3]))};
            *(u32x4*)(Q.SG + (size_t)row * 2048 + (col - GATE)) = o;
          }
        }
      }
    return false;
  }
};
__device__ void phase1(const Params& P, char* smem) {
  g8::Job g; g.A0 = P.xb; g.A1 = P.xb; g.B0 = P.Wtin; g.B1 = P.Wtin; g.lda = 1024; g.K = 1024;
  g8::Order S; S.init(65, NTILE_N1 - 8, (int)gridDim.x, (int)blockIdx.x, 1);
  Epi1 E; E.P = &P; E.pn_off = 0;
  g8::gemm_phase((G8_LAS unsigned char*)smem, g, S, E);
}
__device__ void phase1_gates(const Params& P, char* smem, int nblk, int c) {
  g8::Job g; g.A0 = P.xb; g.A1 = P.xb; g.B0 = P.Wtin + (size_t)(NTILE_N1 - 8) * 256 * 1024; g.B1 = g.B0; g.lda = 1024; g.K = 1024;
  g8::Order S; S.init(65, 8, nblk, c, 1);
  Epi1 E; E.P = &P; E.pn_off = NTILE_N1 - 8;
  g8::gemm_phase((G8_LAS unsigned char*)smem, g, S, E);
}

constexpr int G_QT = 0, G_KT = 17408, G_KHT = 34816, G_VT = 53248, G_AM = 90112, G_ALR = 99328, G_BL = 103424, G_SEG = 103936, G_SSQ = 105984, G_B = 108032, G_EBL = 141824, G_NW = 142336;
__device__ void gla_prompt_unit(const Params& P, char* smem, int b, int hd, bool dry) {
  const int tid = tid_(), lane = tid & 63, wid = __builtin_amdgcn_readfirstlane(tid >> 6), h = lane >> 5, l31 = lane & 31;
  float* ALR = (float*)(smem + G_ALR); float* BL = (float*)(smem + G_BL); float* SEG = (float*)(smem + G_SEG); float* SSQ = (float*)(smem + G_SSQ);
  float* Bc = (float*)(smem + G_B);
  float* EBL = (float*)(smem + G_EBL);
  float* NW = (float*)(smem + G_NW);
  if (tid < 256) NW[tid] = P.gla_nw[tid];
  const int dk = tid & 127, seg = tid >> 7;
  const int li = tid & 63, lg = tid >> 6;
  const int i6 = tid >> 3, sg8 = tid & 7;
  float w2c[16];
#pragma unroll
  for (int j = 0; j < 16; ++j) w2c[j] = P.gla_w2[j * 512 + hd * 128 + dk];
  const float bias = P.gla_b[hd * 128 + dk];
  f32x16 S[4];
#pragma unroll
  for (int kb = 0; kb < 4; ++kb)
#pragma unroll
    for (int e = 0; e < 16; ++e) S[kb][e] = 0.f;
  const float qscale = 0.08838834764831845f;
  u32x4 rq[2], rk[2], rv[4], rga[4]; u32x2 ralr = {0u, 0u};
  u32x4 ost[4];
  auto flush_out = [&](int c) {
    if (dry) return;
    bf16_t* op = P.P + ((size_t)b * 2048 + c * 64 + i6) * LDP + GG + hd * 256 + 32 * sg8;
#pragma unroll
    for (int q4 = 0; q4 < 4; ++q4) *(u32x4*)(op + 8 * q4) = ost[q4];
  };
  auto issue_qkv = [&](int c) {
    const bf16_t* rowp = P.P + ((size_t)b * 2048 + c * 64 + li) * LDP;
#pragma unroll
    for (int it = 0; it < 2; ++it) { rq[it] = *(const u32x4*)(rowp + GQ + hd * 128 + 8 * (lg + 8 * it)); rk[it] = *(const u32x4*)(rowp + GK + hd * 128 + 8 * (lg + 8 * it)); }
#pragma unroll
    for (int it = 0; it < 4; ++it) rv[it] = *(const u32x4*)(rowp + GV + hd * 256 + 8 * (lg + 8 * it));
  };
  auto issue_alr = [&](int c) {
    if (tid < 256) ralr = *(const u32x2*)(P.P + ((size_t)b * 2048 + c * 64 + (tid >> 2)) * LDP + GA + (tid & 3) * 4);
  };
  auto issue_ga = [&](int c) {
    const bf16_t* gp = P.P + ((size_t)b * 2048 + c * 64 + i6) * LDP + GG + hd * 256 + 32 * sg8;
#pragma unroll
    for (int q4 = 0; q4 < 4; ++q4) rga[q4] = *(const u32x4*)(gp + 8 * q4);
  };
  issue_alr(0);

  for (int c = 0; c < 32; ++c) {
    const size_t rb = (size_t)b * 2048 + c * 64;
    issue_qkv(c);
    if (tid < 256) { f32x4 f = {bflo(ralr[0]), bfhi(ralr[0]), bflo(ralr[1]), bfhi(ralr[1])}; *(f32x4*)(ALR + (tid >> 2) * 16 + (tid & 3) * 4) = f; }
    __syncthreads();
    { float bc[16]; float run = 0.f;
#pragma unroll
      for (int ii = 0; ii < 16; ++ii) {
        const int i = 16 * seg + ii; float x = bias;
#pragma unroll
        for (int j4 = 0; j4 < 4; ++j4) { const f32x4 a = *(const f32x4*)(ALR + i * 16 + 4 * j4);
          x += a[0] * w2c[4 * j4] + a[1] * w2c[4 * j4 + 1] + a[2] * w2c[4 * j4 + 2] + a[3] * w2c[4 * j4 + 3]; }
        run += logsig(x) * 0.0625f; bc[ii] = run;
      }
      SEG[seg * 128 + dk] = run;
      __syncthreads();
      float off = 0.f, tot = 0.f;
#pragma unroll
      for (int s = 0; s < 4; ++s) { const float v = SEG[s * 128 + dk]; tot += v; if (s < seg) off += v; }
      if (seg == 0) { BL[dk] = tot; EBL[dk] = __expf(tot); }
#pragma unroll
      for (int ii = 0; ii < 16; ++ii) Bc[(16 * seg + ii) * 132 + dk] = bc[ii] + off; }
    __syncthreads();
#pragma unroll
    for (int it = 0; it < 2; ++it) {
      const int dk0 = 8 * (lg + 8 * it); float qf[8], kf[8], bb[8], tt[8], qt[8], kt[8];
      unpack8(rq[it], qf); unpack8(rk[it], kf); ld8f(Bc + li * 132 + dk0, bb); ld8f(EBL + dk0, tt);
#pragma unroll
      for (int e = 0; e < 8; ++e) { qt[e] = qf[e] * qscale * __expf(bb[e]); kt[e] = kf[e] * __expf(-bb[e]);
        *(bf16_t*)(smem + G_KHT + (dk0 + e) * ROWB + li * 2) = f2bf(kt[e] * tt[e]); }
      *(u32x4*)(smem + G_QT + li * 272 + dk0 * 2) = pack8(qt); *(u32x4*)(smem + G_KT + li * 272 + dk0 * 2) = pack8(kt);
      __builtin_amdgcn_sched_barrier(0);
    }
#pragma unroll
    for (int it = 0; it < 4; ++it) { const int dv0 = 8 * (lg + 8 * it);
#pragma unroll
      for (int e = 0; e < 4; ++e) { *(bf16_t*)(smem + G_VT + (dv0 + 2 * e) * ROWB + li * 2) = (bf16_t)(rv[it][e] & 0xffffu); *(bf16_t*)(smem + G_VT + (dv0 + 2 * e + 1) * ROWB + li * 2) = (bf16_t)(rv[it][e] >> 16); } }
    if (c > 0) flush_out(c - 1);
    __syncthreads();
    issue_ga(c);
    f32x16 o[2];
#pragma unroll
    for (int ib = 0; ib < 2; ++ib)
#pragma unroll
      for (int e = 0; e < 16; ++e) o[ib][e] = 0.f;
#pragma unroll
    for (int kb = 0; kb < 4; ++kb)
#pragma unroll
      for (int s = 0; s < 2; ++s) {
        const bf16x8 sp = pack_acc(S[kb], s);
#pragma unroll
        for (int ib = 0; ib < 2; ++ib) {
          const char* qp = smem + G_QT + (32 * ib + l31) * 272 + (32 * kb + 16 * s + 4 * h) * 2;
          const u32x2 q0 = *(const u32x2*)qp, q1 = *(const u32x2*)(qp + 16);
          u32x4 qq = {q0[0], q0[1], q1[0], q1[1]};
          o[ib] = MFMA(sp, __builtin_bit_cast(bf16x8, qq), o[ib]);
        }
      }
    if (wid < 4) {
      const int bi = wid >> 1, bj = wid & 1;
      f32x16 am;
#pragma unroll
      for (int e = 0; e < 16; ++e) am[e] = 0.f;
      if (wid != 1) {
#pragma unroll
        for (int ks = 0; ks < 8; ++ks) {
          const bf16x8 qf = *(const bf16x8*)(smem + G_QT + (32 * bi + l31) * 272 + ks * 32 + h * 16);
          const bf16x8 kf = *(const bf16x8*)(smem + G_KT + (32 * bj + l31) * 272 + ks * 32 + h * 16);
          am = MFMA(kf, qf, am);
        }
      }
      const int i = 32 * bi + l31;
#pragma unroll
      for (int g4 = 0; g4 < 4; ++g4) { float v[4];
#pragma unroll
        for (int e = 0; e < 4; ++e) { const int j = 32 * bj + 8 * g4 + 4 * h + e; v[e] = (j <= i) ? am[4 * g4 + e] : 0.f; }
        u32x2 ov = {pk2(v[0], v[1]), pk2(v[2], v[3])};
        *(u32x2*)(smem + G_AM + i * ROWB + (32 * bj + 8 * g4 + 4 * h) * 2) = ov; }
    }
    __syncthreads();
    { bf16x8 vf[4];
#pragma unroll
      for (int ks = 0; ks < 4; ++ks) vf[ks] = *(const bf16x8*)(smem + G_VT + (32 * wid + l31) * ROWB + ks * 32 + h * 16);
#pragma unroll
      for (int ib = 0; ib < 2; ++ib)
#pragma unroll
        for (int ks = 0; ks < 4; ++ks) { const bf16x8 af = *(const bf16x8*)(smem + G_AM + (32 * ib + l31) * ROWB + ks * 32 + h * 16);
          o[ib] = MFMA(vf[ks], af, o[ib]); }
#pragma unroll
      for (int kb = 0; kb < 4; ++kb) {
#pragma unroll
        for (int g4 = 0; g4 < 4; ++g4) { const f32x4 bl = *(const f32x4*)(EBL + 32 * kb + 8 * g4 + 4 * h);
#pragma unroll
          for (int e = 0; e < 4; ++e) S[kb][4 * g4 + e] *= bl[e]; }
#pragma unroll
        for (int ks = 0; ks < 4; ++ks) { const bf16x8 kf = *(const bf16x8*)(smem + G_KHT + (32 * kb + l31) * ROWB + ks * 32 + h * 16);
          S[kb] = MFMA(kf, vf[ks], S[kb]); }
      } }
#pragma unroll
    for (int ib = 0; ib < 2; ++ib) { float s = 0.f;
#pragma unroll
      for (int e = 0; e < 16; ++e) s += o[ib][e] * o[ib][e];
      s += __shfl_xor(s, 32);
      if (lane < 32) SSQ[wid * 64 + 32 * ib + lane] = s; }
    __syncthreads();
    if (c + 1 < 32) issue_alr(c + 1);
#pragma unroll
    for (int ib = 0; ib < 2; ++ib)
#pragma unroll
      for (int g4 = 0; g4 < 4; ++g4) { u32x2 ov = {pk2(o[ib][4 * g4], o[ib][4 * g4 + 1]), pk2(o[ib][4 * g4 + 2], o[ib][4 * g4 + 3])};
        *(u32x2*)(smem + (32 * ib + l31) * 528 + (32 * wid + 8 * g4 + 4 * h) * 2) = ov; }
    __syncthreads();
    { float ss = 0.f;
#pragma unroll
      for (int w = 0; w < 8; ++w) ss += SSQ[w * 64 + i6];
      const float rs = rsqrtf(ss * (1.f / 256.f) + 1e-5f);
#pragma unroll
      for (int q4 = 0; q4 < 4; ++q4) { const int dv0 = 32 * sg8 + 8 * q4;
        float ov[8], gv[8], nw[8];
        unpack8(*(const u32x4*)(smem + i6 * 528 + dv0 * 2), ov);
        unpack8(rga[q4], gv);
        ld8f(NW + dv0, nw);
#pragma unroll
        for (int e = 0; e < 8; ++e) ov[e] = ov[e] * rs * nw[e] * silu(gv[e]);
        ost[q4] = pack8(ov); }
    }
  }
  flush_out(31);
#pragma unroll
  for (int kb = 0; kb < 4; ++kb)
#pragma unroll
    for (int e = 0; e < 16; ++e)
      P.out[O_GLAP + ((size_t)(b * 4 + hd) * 128 + 32 * kb + crow(e, h)) * 256 + 32 * wid + l31] = S[kb][e];
  __syncthreads();
}

constexpr int PB_KAP = 0, PB_RHO = 4608, PB_ALPT = 9216, PB_BETT = 14336, PB_VT = 19456, PB_TT = 24576, PB_NB = 27136, PB_MA = 29696, PB_MB = 32256, PB_CT = 34816, PB_SIZE = 35328;
constexpr int X_PB = 0, X_Y = 70656, X_GB = 87040, X_W2T = 95232, X_A2T = 104448, X_LIN = 113664, X_ARG = 122880, X_C3 = 139264, X_SEG = 140288,
              X_CONST = 142336, X_TS = 145664;
constexpr int R40 = 80;
DI bf16x8 ld_perm(const char* p) { const u32x2 q0 = *(const u32x2*)p, q1 = *(const u32x2*)(p + 16); u32x4 q = {q0[0], q0[1], q1[0], q1[1]}; return __builtin_bit_cast(bf16x8, q); }
DI void unpack4(u32x2 v, float (&f)[4]) { f[0] = bflo(v[0]); f[1] = bfhi(v[0]); f[2] = bflo(v[1]); f[3] = bfhi(v[1]); }
DI u32x2 pack4(const float (&f)[4]) { u32x2 o = {pk2(f[0], f[1]), pk2(f[2], f[3])}; return o; }
DI void ld4f(const float* p, float (&f)[4]) { const f32x4 a = *(const f32x4*)p; f[0] = a[0]; f[1] = a[1]; f[2] = a[2]; f[3] = a[3]; }
DI float red16(float x) {
  x = red8(x);
  x += __builtin_bit_cast(float, __builtin_amdgcn_update_dpp(0, __builtin_bit_cast(int, x), 0x140, 0xF, 0xF, true));
  return x;
}
__device__ void rwkv_prompt_unit(const Params& P, char* smem, int b, int hd, bool dry) {
  const int tid = tid_(), lane = tid & 63, wid = __builtin_amdgcn_readfirstlane(tid >> 6), h = lane >> 5, l31 = lane & 31;
  const int t = tid >> 4, cq = tid & 15, c4 = cq * 4, hc = hd * 64 + c4;
  { const int j = tid >> 3; const int cc8 = (tid & 7) * 8; float f[8], g[8];
    ld8f(P.w2 + j * 1024 + hd * 64 + cc8, f); ld8f(P.a2 + j * 1024 + hd * 64 + cc8, g);
#pragma unroll
    for (int e = 0; e < 8; ++e) { *(bf16_t*)(smem + X_W2T + (cc8 + e) * ROWB + j * 2) = f2bf(f[e]); *(bf16_t*)(smem + X_A2T + (cc8 + e) * ROWB + j * 2) = f2bf(g[e]); } }
  f32x16 St[2];
#pragma unroll
  for (int kb = 0; kb < 2; ++kb)
#pragma unroll
    for (int e = 0; e < 16; ++e) St[kb][e] = 0.f;
  float* CONSTS = (float*)(smem + X_CONST);
  if (tid < 64) { const int c = hd * 64 + tid;
    CONSTS[tid] = P.mu[c]; CONSTS[64 + tid] = P.mu[1024 + c]; CONSTS[128 + tid] = P.mu[2048 + c]; CONSTS[192 + tid] = P.mu[3072 + c];
    CONSTS[256 + tid] = P.w0[c]; CONSTS[320 + tid] = P.a0[c]; CONSTS[384 + tid] = P.k_k[c]; CONSTS[448 + tid] = P.k_a[c]; CONSTS[512 + tid] = P.r_k[c];
    CONSTS[576 + tid] = P.lnx_w[c]; CONSTS[640 + tid] = P.lnx_b[c]; CONSTS[704 + tid] = P.mu[4096 + tid]; CONSTS[768 + tid] = P.mu[4160 + tid]; }
  __syncthreads();

  for (int it = -1; it < 65; ++it) {
    const int kp = it + 1;
    const bool do_pre = kp < 64, do_post = it >= 1, do_cons = it >= 0 && it < 64;
    u32x2 Lw, La, Lwq, Laq, Lr, Lk, Lv, Lg, Lrq, Lkq, Lvq, Lgq;
    const size_t r = (size_t)b * 2048 + (size_t)(do_pre ? kp : 0) * 32 + t;
    const bool first = (kp == 0 && t == 0);
    const int p = kp & 1;
    char* PB = smem + X_PB + p * PB_SIZE;
    float* WARG = (float*)(smem + X_ARG); float* LW = WARG + 2048;
    float* C3 = (float*)(smem + X_C3) + p * 128; float* SEGT = (float*)(smem + X_SEG); float* CT = (float*)(PB + PB_CT);
    if (do_pre) {
      const bf16_t* pr = P.P + r * LDP; const bf16_t* pq = first ? P.P + (size_t)TT * LDP : pr - LDP;
      Lw = *(const u32x2*)(pr + RWL + c4); La = *(const u32x2*)(pr + RAL + c4); Lwq = *(const u32x2*)(pq + RWL + c4); Laq = *(const u32x2*)(pq + RAL + c4);
      Lr = *(const u32x2*)(pr + RR + hc); Lk = *(const u32x2*)(pr + RK + hc); Lv = *(const u32x2*)(pr + RV + hc); Lg = *(const u32x2*)(pr + RG + hc);
      Lrq = *(const u32x2*)(pq + RR + hc); Lkq = *(const u32x2*)(pq + RK + hc); Lvq = *(const u32x2*)(pq + RV + hc); Lgq = *(const u32x2*)(pq + RG + hc);
    }
    u32x2 post_val = {0u, 0u};
    if (do_post) {
      const int k = it - 1, pp = k & 1;
      const float* Y = (const float*)(smem + X_Y) + pp * 2048; const char* VT = smem + X_PB + pp * PB_SIZE + PB_VT;
      float y[4]; ld4f(Y + t * 64 + c4, y);
      const float mean = red16(y[0] + y[1] + y[2] + y[3]) * (1.f / 64.f); float q = 0.f;
#pragma unroll
      for (int e = 0; e < 4; ++e) { y[e] -= mean; q += y[e] * y[e]; }
      const float rs = rsqrtf(red16(q) * (1.f / 64.f) + 64e-5f);
      const float c3 = ((const float*)(smem + X_C3))[pp * 128 + t * 4 + 2]; float gg[4], lnw[4], lnb[4];
      ld4f(CONSTS + 576 + c4, lnw); ld4f(CONSTS + 640 + c4, lnb);
      unpack4(*(const u32x2*)(smem + X_GB + pp * 4096 + t * 128 + c4 * 2), gg);
#pragma unroll
      for (int e = 0; e < 4; ++e) { const float vv = bf2f(*(const bf16_t*)(VT + (c4 + e) * R40 + t * 2)); y[e] = (y[e] * rs * lnw[e] + lnb[e] + c3 * vv) * silu(gg[e]); }
      post_val = pack4(y);
    }
    float rr[4], kk[4], kka[4], km[4], lw[4];
    if (do_pre) {
      { float pw[4], pa[4], qw[4], qa[4], mw[4], ma[4];
        unpack4(Lw, pw); unpack4(La, pa); unpack4(Lwq, qw); unpack4(Laq, qa);
        ld4f(CONSTS + 704 + c4, mw); ld4f(CONSTS + 768 + c4, ma);
#pragma unroll
        for (int e = 0; e < 4; ++e) {
          pw[e] = tanh_(pw[e] + (qw[e] - pw[e]) * mw[e]); pa[e] = pa[e] + (qa[e] - pa[e]) * ma[e]; }
        *(u32x2*)(smem + X_LIN + t * ROWB + c4 * 2) = pack4(pw); *(u32x2*)(smem + X_LIN + 4608 + t * ROWB + c4 * 2) = pack4(pa); }
    }
    __syncthreads();
    if (do_pre && wid < 4) {
      const int mm = wid >> 1, ni = wid & 1;
      f32x16 d;
#pragma unroll
      for (int e = 0; e < 16; ++e) d[e] = 0.f;
#pragma unroll
      for (int ks = 0; ks < 4; ++ks) {
        const bf16x8 af = *(const bf16x8*)(smem + X_LIN + mm * 4608 + l31 * ROWB + ks * 32 + h * 16);
        const bf16x8 bf = *(const bf16x8*)(smem + (mm ? X_A2T : X_W2T) + (32 * ni + l31) * ROWB + ks * 32 + h * 16);
        d = MFMA(af, bf, d);
      }
      float* dst = WARG + mm * 2048;
#pragma unroll
      for (int e = 0; e < 16; ++e) dst[crow(e, h) * 64 + 32 * ni + l31] = d[e];
    }
    __syncthreads();
    if (do_pre) {
      float pr[4], pk[4], pv[4], pg[4], qr[4], qk[4], qv[4], qg[4];
      unpack4(Lr, pr); unpack4(Lk, pk); unpack4(Lv, pv); unpack4(Lg, pg); unpack4(Lrq, qr); unpack4(Lkq, qk); unpack4(Lvq, qv); unpack4(Lgq, qg);
      float mur[4], muk[4], muv[4], mug[4], w0v[4], a0v[4], kkw[4], kaw[4], rkw[4];
      ld4f(CONSTS + c4, mur); ld4f(CONSTS + 64 + c4, muk); ld4f(CONSTS + 128 + c4, muv); ld4f(CONSTS + 192 + c4, mug);
      ld4f(CONSTS + 256 + c4, w0v); ld4f(CONSTS + 320 + c4, a0v); ld4f(CONSTS + 384 + c4, kkw); ld4f(CONSTS + 448 + c4, kaw); ld4f(CONSTS + 512 + c4, rkw);
      float ssq = 0.f, s3 = 0.f; float gg[4];
#pragma unroll
      for (int e = 0; e < 4; ++e) {
        rr[e] = pr[e] + (qr[e] - pr[e]) * mur[e];
        const float kb = pk[e] + (qk[e] - pk[e]) * muk[e];
        const float vv = pv[e] + (qv[e] - pv[e]) * muv[e];
        gg[e] = pg[e] + (qg[e] - pg[e]) * mug[e];
        const float wa = WARG[t * 64 + c4 + e] + w0v[e];
        lw[e] = -0.606531f * sigm(wa);
        const float a = sigm(LW[t * 64 + c4 + e] + a0v[e]);
        kk[e] = kb * kkw[e]; ssq += kk[e] * kk[e];
        km[e] = kb * (1.f + (a - 1.f) * kaw[e]);
        kka[e] = a;
        s3 += rr[e] * km[e] * rkw[e];
        *(bf16_t*)(PB + PB_VT + (c4 + e) * R40 + t * 2) = f2bf(vv);
      }
      ssq = red16(ssq);
      const float inv = __builtin_amdgcn_rcpf(fmaxf(sqrtf(ssq), 1e-12f));
#pragma unroll
      for (int e = 0; e < 4; ++e) { kk[e] *= inv; kka[e] *= kk[e]; }
      s3 = red16(s3);
      if (cq == 0) C3[t * 4 + 2] = s3;
      { f32x4 lwv = {lw[0], lw[1], lw[2], lw[3]}; *(f32x4*)(LW + t * 64 + c4) = lwv; }
      *(u32x2*)(smem + X_GB + p * 4096 + t * 128 + c4 * 2) = pack4(gg);
    }
    asm volatile("s_waitcnt lgkmcnt(0)" ::: "memory");
    float run = 0.f; const int cc = tid & 63, ts = tid >> 6;
    if (do_pre) {
#pragma unroll
      for (int e = 0; e < 4; ++e) { run += LW[(4 * ts + e) * 64 + cc]; LW[(4 * ts + e) * 64 + cc] = run; }
      SEGT[ts * 64 + cc] = run;
    }
    __syncthreads();
    if (do_pre) {
      float ka[4], ro[4], al[4], be[4];
      f32x4 cumv = *(const f32x4*)(LW + t * 64 + c4);
      for (int s2_ = 0; s2_ < (t >> 2); ++s2_) cumv += *(const f32x4*)(SEGT + s2_ * 64 + c4);
      if (t == 31) *(f32x4*)(CT + c4) = cumv;
#pragma unroll
      for (int e = 0; e < 4; ++e) {
        const float cum = cumv[e], cprev = cum - lw[e];
        const float Ct = __expf(cum), Cp = __expf(cprev), iC = __expf(-cum);
        ka[e] = -kk[e] * Cp; ro[e] = rr[e] * Ct; al[e] = kka[e] * iC; be[e] = km[e] * iC;
        *(bf16_t*)(PB + PB_ALPT + (c4 + e) * R40 + t * 2) = f2bf(al[e]); *(bf16_t*)(PB + PB_BETT + (c4 + e) * R40 + t * 2) = f2bf(be[e]);
      }
      *(u32x2*)(PB + PB_KAP + t * ROWB + c4 * 2) = pack4(ka); *(u32x2*)(PB + PB_RHO + t * ROWB + c4 * 2) = pack4(ro);
      *(u32x2*)(smem + X_LIN + t * ROWB + c4 * 2) = pack4(al); *(u32x2*)(smem + X_LIN + 4608 + t * ROWB + c4 * 2) = pack4(be);
    }
    __syncthreads();
    if (do_post && !dry) *(u32x2*)(P.P + ((size_t)b * 2048 + (size_t)(it - 1) * 32 + t) * LDP + RG + hc) = post_val;
    if (do_pre && wid >= 4) {
      const int hw = wid - 4;
      const char* xa = PB + ((hw & 2) ? PB_RHO : PB_KAP); const char* ya = smem + X_LIN + ((hw & 1) ? 4608 : 0);
      f32x16 d;
#pragma unroll
      for (int e = 0; e < 16; ++e) d[e] = 0.f;
#pragma unroll
      for (int ks = 0; ks < 4; ++ks) {
        const bf16x8 yf = *(const bf16x8*)(ya + l31 * ROWB + ks * 32 + h * 16);
        const bf16x8 xf = *(const bf16x8*)(xa + l31 * ROWB + ks * 32 + h * 16);
        d = MFMA(yf, xf, d);
      }
      const bool incl = (hw & 2) != 0;
      int lt = l31; asm volatile("" : "+v"(lt));
#pragma unroll
      for (int e = 0; e < 16; ++e) { const int j = crow(e, h); d[e] = (incl ? (j <= lt) : (j < lt)) ? d[e] : 0.f; }
      if (hw != 0) {
        char* dst = PB + (hw == 1 ? PB_NB : (hw == 2 ? PB_MA : PB_MB));
#pragma unroll
        for (int g4 = 0; g4 < 4; ++g4) { u32x2 ov = {pk2(d[4 * g4], d[4 * g4 + 1]), pk2(d[4 * g4 + 2], d[4 * g4 + 3])};
          *(u32x2*)(dst + lt * R40 + (8 * g4 + 4 * h) * 2) = ov; }
      } else {
        char* Qrow = smem + X_TS;
        __builtin_amdgcn_s_setprio(3);
        f32x16 pa = d;
#pragma unroll
        for (int e = 0; e < 16; ++e) if (crow(e, h) == lt) pa[e] += 1.f;
#pragma unroll
        for (int e = 0; e < 16; ++e) *(bf16_t*)(Qrow + crow(e, h) * R40 + lt * 2) = f2bf(d[e]);
#pragma unroll 1
        for (int i = 0; i < 4; ++i) {
          asm volatile("" ::: "memory");
          f32x16 qn;
#pragma unroll
          for (int e = 0; e < 16; ++e) qn[e] = 0.f;
          const bf16x8 qa0 = ld_perm(Qrow + lt * R40 + (4 * h) * 2), qa1 = ld_perm(Qrow + lt * R40 + (16 + 4 * h) * 2);
          qn = MFMA(qa0, pack_acc(d, 0), qn); qn = MFMA(qa1, pack_acc(d, 1), qn);
          d = qn;
#pragma unroll
          for (int e = 0; e < 16; ++e) *(bf16_t*)(Qrow + crow(e, h) * R40 + lt * 2) = f2bf(d[e]);
          asm volatile("" ::: "memory");
          const bf16x8 qb0 = ld_perm(Qrow + lt * R40 + (4 * h) * 2), qb1 = ld_perm(Qrow + lt * R40 + (16 + 4 * h) * 2);
          const bf16x8 pp0 = pack_acc(pa, 0), pp1 = pack_acc(pa, 1);
          pa = MFMA(qb0, pp0, pa); pa = MFMA(qb1, pp1, pa);
        }
#pragma unroll
        for (int g4 = 0; g4 < 4; ++g4) { u32x2 ov = {pk2(pa[4 * g4], pa[4 * g4 + 1]), pk2(pa[4 * g4 + 2], pa[4 * g4 + 3])};
          *(u32x2*)(PB + PB_TT + lt * R40 + (8 * g4 + 4 * h) * 2) = ov; }
        __builtin_amdgcn_s_setprio(0);
      }
    } else if (do_cons && wid < 2) {
      const int pc = it & 1; const char* PC = smem + X_PB + pc * PB_SIZE; const int vrow = 32 * wid + l31;
      bf16x8 sp[2][2];
#pragma unroll
      for (int kb = 0; kb < 2; ++kb)
#pragma unroll
        for (int s = 0; s < 2; ++s) sp[kb][s] = pack_acc(St[kb], s);
      bf16x8 vf[2];
#pragma unroll
      for (int s = 0; s < 2; ++s) vf[s] = *(const bf16x8*)(PC + PB_VT + vrow * R40 + (16 * s + 8 * h) * 2);
      f32x16 X, Y;
#pragma unroll
      for (int e = 0; e < 16; ++e) { X[e] = 0.f; Y[e] = 0.f; }
#pragma unroll
      for (int kb = 0; kb < 2; ++kb)
#pragma unroll
        for (int s = 0; s < 2; ++s) {
          X = MFMA(ld_perm(PC + PB_KAP + l31 * ROWB + (32 * kb + 16 * s + 4 * h) * 2), sp[kb][s], X);
          Y = MFMA(ld_perm(PC + PB_RHO + l31 * ROWB + (32 * kb + 16 * s + 4 * h) * 2), sp[kb][s], Y);
        }
#pragma unroll
      for (int s = 0; s < 2; ++s) {
        X = MFMA(*(const bf16x8*)(PC + PB_NB + l31 * R40 + (16 * s + 8 * h) * 2), vf[s], X);
        Y = MFMA(*(const bf16x8*)(PC + PB_MB + l31 * R40 + (16 * s + 8 * h) * 2), vf[s], Y);
      }
      f32x16 U;
#pragma unroll
      for (int e = 0; e < 16; ++e) U[e] = 0.f;
#pragma unroll
      for (int s = 0; s < 2; ++s) U = MFMA(ld_perm(PC + PB_TT + l31 * R40 + (16 * s + 4 * h) * 2), pack_acc(X, s), U);
      bf16x8 up[2];
#pragma unroll
      for (int s = 0; s < 2; ++s) up[s] = pack_acc(U, s);
#pragma unroll
      for (int s = 0; s < 2; ++s) Y = MFMA(ld_perm(PC + PB_MA + l31 * R40 + (16 * s + 4 * h) * 2), up[s], Y);
      { float* Yo = (float*)(smem + X_Y) + pc * 2048;
#pragma unroll
        for (int e = 0; e < 16; ++e) Yo[crow(e, h) * 64 + vrow] = Y[e]; }
      const float* CTc = (const float*)(PC + PB_CT);
#pragma unroll
      for (int kb = 0; kb < 2; ++kb) {
#pragma unroll
        for (int s = 0; s < 2; ++s) {
          St[kb] = MFMA(ld_perm(PC + PB_ALPT + (32 * kb + l31) * R40 + (16 * s + 4 * h) * 2), up[s], St[kb]);
          St[kb] = MFMA(*(const bf16x8*)(PC + PB_BETT + (32 * kb + l31) * R40 + (16 * s + 8 * h) * 2), vf[s], St[kb]);
        }
#pragma unroll
        for (int g4 = 0; g4 < 4; ++g4) { const f32x4 ct = *(const f32x4*)(CTc + 32 * kb + 8 * g4 + 4 * h);
#pragma unroll
          for (int e = 0; e < 4; ++e) St[kb][4 * g4 + e] *= __expf(ct[e]); }
      }
    }
    __syncthreads();
  }
  if (wid < 2) {
#pragma unroll
    for (int kb = 0; kb < 2; ++kb)
#pragma unroll
      for (int g4 = 0; g4 < 4; ++g4) { f32x4 o = {St[kb][4 * g4], St[kb][4 * g4 + 1], St[kb][4 * g4 + 2], St[kb][4 * g4 + 3]};
        *(f32x4*)(P.out + O_RWKVP + ((size_t)(b * 16 + hd) * 64 + 32 * wid + l31) * 64 + 32 * kb + 8 * g4 + 4 * h) = o; }
  }
  __syncthreads();
}

__device__ void gla_sample_unit(const Params& P, char* smem, int sb, int hd, bool dry) {
  const int tid = tid_();
  float* AD = (float*)smem; float* Qs = AD + 128; float* Ks = Qs + 128; float* Vs = Ks + 128; float* OP = Vs + 256; float* RED = OP + 2048;
  const size_t r = (size_t)TP + sb;
  if (tid < 128) { const int dk = tid; float x = P.gla_b[hd * 128 + dk];
#pragma unroll
    for (int j = 0; j < 16; ++j) x += bf2f(P.P[r * LDP + GA + j]) * P.gla_w2[j * 512 + hd * 128 + dk];
    AD[dk] = __expf(logsig(x) * 0.0625f);
    Qs[dk] = bf2f(P.P[r * LDP + GQ + hd * 128 + dk]) * 0.08838834764831845f; Ks[dk] = bf2f(P.P[r * LDP + GK + hd * 128 + dk]); }
  else if (tid < 384) { const int dv = tid - 128; Vs[dv] = bf2f(P.P[r * LDP + GV + hd * 256 + dv]); }
  __syncthreads();
  { const int dv4 = (tid & 63) * 4, ds = tid >> 6; f32x4 oacc = {0.f, 0.f, 0.f, 0.f}; const f32x4 v4 = *(const f32x4*)(Vs + dv4);
    const size_t base = ((size_t)(sb * 4 + hd) * 128) * 256;
    f32x4 sin[16];
#pragma unroll
    for (int e = 0; e < 16; ++e) sin[e] = *(const f32x4*)(P.state_gla + base + (size_t)(16 * ds + e) * 256 + dv4);
#pragma unroll
    for (int e = 0; e < 16; ++e) { const int dk = 16 * ds + e;
      const f32x4 s4 = sin[e];
      const f32x4 sn = s4 * AD[dk] + v4 * Ks[dk];
      *(f32x4*)(P.out + O_GLAS + base + (size_t)dk * 256 + dv4) = sn;
      oacc += sn * Qs[dk]; }
    *(f32x4*)(OP + ds * 256 + dv4) = oacc; }
  __syncthreads();
  float ov = 0.f;
  if (tid < 256) { for (int s = 0; s < 8; ++s) ov += OP[s * 256 + tid]; const float q = red64(ov * ov); if ((tid & 63) == 0) RED[tid >> 6] = q; }
  __syncthreads();
  if (tid < 256) { const float rs = rsqrtf((RED[0] + RED[1] + RED[2] + RED[3]) * (1.f / 256.f) + 1e-5f);
    bf16_t* gp = P.P + r * LDP + GG + hd * 256 + tid;
    const bf16_t res = f2bf(ov * rs * P.gla_nw[tid] * silu(bf2f(*gp))); if (!dry) *gp = res; }
  __syncthreads();
}

__device__ void rwkv_sample_unit(const Params& P, char* smem, int sb, int half, bool dry) {
  const int tid = tid_(), lane = tid & 63, wid = tid >> 6;
  float* LWv = (float*)smem; float* LAv = LWv + 64; float* KK = LAv + 64; float* WW = KK + 512; float* KA = WW + 512; float* KM = KA + 512;
  float* RRv = KM + 512; float* VVv = RRv + 512; float* GBv = VVv + 512; float* Yv = GBv + 512; float* BON = Yv + 512;
  const size_t r = (size_t)TP + sb; const float* sh = P.state_shift + (size_t)sb * 4224;
  if (tid < 64) { const int j = tid;
    const float pw = bf2f(P.P[r * LDP + RWL + j]), pa = bf2f(P.P[r * LDP + RAL + j]);
    LWv[j] = tanh_(pw + (sh[4096 + j] - pw) * P.mu[4096 + j]); LAv[j] = pa + (sh[4160 + j] - pa) * P.mu[4160 + j]; }
  __syncthreads();
  { const int c = half * 512 + tid;
    float wa = P.w0[c], aa = P.a0[c];
#pragma unroll 32
    for (int j = 0; j < 64; ++j) { wa += LWv[j] * P.w2[j * 1024 + c]; aa += LAv[j] * P.a2[j * 1024 + c]; }
    const float pr = bf2f(P.P[r * LDP + RR + c]), pk = bf2f(P.P[r * LDP + RK + c]), pv = bf2f(P.P[r * LDP + RV + c]), pg = bf2f(P.P[r * LDP + RG + c]);
    const float rr = pr + (sh[c] - pr) * P.mu[c], kb = pk + (sh[1024 + c] - pk) * P.mu[1024 + c];
    const float vv = pv + (sh[2048 + c] - pv) * P.mu[2048 + c], gg = pg + (sh[3072 + c] - pg) * P.mu[3072 + c];
    const float w = __expf(-0.606531f * sigm(wa)), a = sigm(aa);
    float kk = kb * P.k_k[c]; const float nrm = sqrtf(red64(kk * kk)); kk = kk / fmaxf(nrm, 1e-12f);
    const float km = kb * (1.f + (a - 1.f) * P.k_a[c]);
    const float bon = red64(rr * km * P.r_k[c]);
    KK[tid] = -kk; WW[tid] = w; KA[tid] = kk * a; KM[tid] = km; RRv[tid] = rr; VVv[tid] = vv; GBv[tid] = gg; if (lane == 0) BON[wid] = bon; }
  __syncthreads();
  { const int row = tid >> 3, c8 = (tid & 7) * 8;
    float sall[8][8];
#pragma unroll
    for (int hh = 0; hh < 8; ++hh) ld8f(P.state_rwkv + ((size_t)(sb * 16 + half * 8 + hh) * 64 + row) * 64 + c8, sall[hh]);
#pragma unroll
    for (int hh = 0; hh < 8; ++hh) {
      const size_t base = ((size_t)(sb * 16 + half * 8 + hh) * 64 + row) * 64 + c8;
      float s[8]; float d = 0.f;
#pragma unroll
      for (int e = 0; e < 8; ++e) s[e] = sall[hh][e];
#pragma unroll
      for (int e = 0; e < 8; ++e) d += s[e] * KK[hh * 64 + c8 + e];
      const float sa = red8(d); const float vv = VVv[hh * 64 + row]; float y = 0.f;
#pragma unroll
      for (int e = 0; e < 8; ++e) { s[e] = s[e] * WW[hh * 64 + c8 + e] + sa * KA[hh * 64 + c8 + e] + vv * KM[hh * 64 + c8 + e]; y += s[e] * RRv[hh * 64 + c8 + e]; }
      f32x4 o0 = {s[0], s[1], s[2], s[3]}, o1 = {s[4], s[5], s[6], s[7]};
      *(f32x4*)(P.out + O_RWKVS + base) = o0; *(f32x4*)(P.out + O_RWKVS + base + 4) = o1;
      y = red8(y); if ((tid & 7) == 0) Yv[hh * 64 + row] = y;
    } }
  __syncthreads();
  { const int c = half * 512 + tid; const float y = Yv[tid]; const float mean = red64(y) * (1.f / 64.f); const float dd = y - mean;
    const float var = red64(dd * dd) * (1.f / 64.f);
    const float o = (dd * rsqrtf(var + 64e-5f) * P.lnx_w[c] + P.lnx_b[c] + BON[wid] * VVv[tid]) * silu(GBv[tid]);
    if (!dry) P.P[r * LDP + RG + c] = f2bf(o); }
  __syncthreads();
}

DI void blk_publish(unsigned* cnt) {
  asm volatile("s_waitcnt vmcnt(0)" ::: "memory");
  __syncthreads();
  if (threadIdx.x == 0) { __builtin_amdgcn_fence(__ATOMIC_RELEASE, "agent"); asm volatile("s_waitcnt vmcnt(0)" ::: "memory");
    __hip_atomic_fetch_add(cnt, 1u, __ATOMIC_RELAXED, __HIP_MEMORY_SCOPE_AGENT); }
}
DI void blk_wait(unsigned* cnt, unsigned target) {
  if (threadIdx.x == 0) { while (__hip_atomic_load(cnt, __ATOMIC_RELAXED, __HIP_MEMORY_SCOPE_AGENT) < target) __builtin_amdgcn_s_sleep(2);
    __builtin_amdgcn_fence(__ATOMIC_ACQUIRE, "agent"); asm volatile("s_waitcnt vmcnt(0)" ::: "memory"); }
  __syncthreads();
}
constexpr int C_PA = 384, C_SA = 448, C_PB = 512, C_SB = 576, C_BD = 640, C_QO = 704;
__device__ void phase2(const Params& P, char* smem, int roles, bool dry) {
  const int bid = blockIdx.x;
  if (bid < 128) { if (roles & 1) rwkv_prompt_unit(P, smem, bid >> 4, bid & 15, dry); if (!dry) blk_publish(P.ctr + C_BD + (bid >> 4)); }
  else if (bid < 160) { if (roles & 2) gla_prompt_unit(P, smem, (bid - 128) >> 2, (bid - 128) & 3, dry); if (!dry) blk_publish(P.ctr + C_BD + ((bid - 128) >> 2)); }
  const int tid = tid_();
  if (!dry) {
    const unsigned ngate = gridDim.x - 160;
    if (bid >= 160) {
      phase1_gates(P, smem, (int)ngate, bid - 160);
      asm volatile("s_waitcnt vmcnt(0)" ::: "memory");
      __syncthreads();
      if (tid == 0) { __builtin_amdgcn_fence(__ATOMIC_RELEASE, "agent"); __hip_atomic_fetch_add(P.ctr + 192, 1u, __ATOMIC_RELAXED, __HIP_MEMORY_SCOPE_AGENT); }
    }
    if (tid == 0) { while (__hip_atomic_load(P.ctr + 192, __ATOMIC_RELAXED, __HIP_MEMORY_SCOPE_AGENT) < ngate) __builtin_amdgcn_s_sleep(8); __builtin_amdgcn_fence(__ATOMIC_ACQUIRE, "agent"); }
    __syncthreads();
  }
  if (!(roles & 4)) return;
  unsigned* ctr = dry ? P.ctr + 128 : P.ctr;
  int* slot = (int*)(smem + SMEM_BYTES - 16);
  for (;;) {
    if (tid == 0) *slot = (int)atomicAdd(ctr, 1u);
    __syncthreads();
    const int u = *slot;
    __syncthreads();
    if (u >= 512 + 256) break;
    if (u < 512) gla_sample_unit(P, smem, u >> 2, u & 3, dry);
    else rwkv_sample_unit(P, smem, (u - 512) >> 1, (u - 512) & 1, dry);
  }
  if (!dry) blk_publish(P.ctr + C_QO);
}

DI float mini_gemm(const bf16_t* A, int lda, const bf16_t* Bt, int K, int r0, int c0, float* red) {
  const int tid = tid_(), lane = tid & 63, wid = tid >> 6, fr = lane & 15, fq = lane >> 4;
  f32x4 acc0 = {0.f, 0.f, 0.f, 0.f}, acc1 = {0.f, 0.f, 0.f, 0.f};
  const int kb = wid * 128;
  bf16x8 a0[4], a1[4], bb[4];
#pragma unroll
  for (int k = 0; k < 4; ++k) {
    a0[k] = *(const bf16x8*)(A + (size_t)(r0 + fr) * lda + kb + k * 32 + fq * 8); a1[k] = *(const bf16x8*)(A + (size_t)(r0 + 16 + fr) * lda + kb + k * 32 + fq * 8);
    bb[k] = *(const bf16x8*)(Bt + (size_t)(c0 + fr) * K + kb + k * 32 + fq * 8); }
#pragma unroll
  for (int k = 0; k < 4; ++k) {
    acc0 = __builtin_amdgcn_mfma_f32_16x16x32_bf16(a0[k], bb[k], acc0, 0, 0, 0);
    acc1 = __builtin_amdgcn_mfma_f32_16x16x32_bf16(a1[k], bb[k], acc1, 0, 0, 0);
  }
  __syncthreads();
#pragma unroll
  for (int j = 0; j < 4; ++j) { red[wid * 512 + (4 * fq + j) * 16 + fr] = acc0[j]; red[wid * 512 + (16 + 4 * fq + j) * 16 + fr] = acc1[j]; }
  __syncthreads();
  float v = 0.f;
#pragma unroll
  for (int w = 0; w < 8; ++w) v += red[w * 512 + tid];
  return v;
}

struct Epi3a {
  const Params* P;
  DI bool operator()(f32x4 (&acc)[2][2][4][2], const g8::Unit& u, int wr, int wc, int fr, int fq) const {
    const Params& Q = *P;
#pragma unroll
    for (int ai = 0; ai < 2; ++ai) {
      u32x4 gbv[4][2];
#pragma unroll
      for (int m = 0; m < 4; ++m)
#pragma unroll
        for (int bj = 0; bj < 2; ++bj) {
          const int row = u.pm * 256 + ai * 128 + wr * 64 + m * 16 + fr, col = u.pn * 256 + bj * 128 + wc * 32 + 8 * fq;
          gbv[m][bj] = *(const u32x4*)(Q.SG + (size_t)row * 2048 + 1024 + col); }
#pragma unroll
      for (int m = 0; m < 4; ++m) {
        const int row = u.pm * 256 + ai * 128 + wr * 64 + m * 16 + fr;
#pragma unroll
        for (int bj = 0; bj < 2; ++bj) {
          const int col = u.pn * 256 + bj * 128 + wc * 32 + 8 * fq;
          float gb[8]; unpack8(gbv[m][bj], gb);
          if (u.sub == 0) {
            float ga[8]; unpack8(*(const u32x4*)(Q.SG + (size_t)row * 2048 + col), ga);
#pragma unroll
            for (int j = 0; j < 4; ++j) { acc[ai][bj][m][0][j] *= ga[j] * __builtin_amdgcn_rcpf(gb[j]); acc[ai][bj][m][1][j] *= ga[4 + j] * __builtin_amdgcn_rcpf(gb[4 + j]); }
          } else {
            const f32x4 v0 = acc[ai][bj][m][0], v1 = acc[ai][bj][m][1];
            u32x4 o = {pk2(gb[0] * v0[0], gb[1] * v0[1]), pk2(gb[2] * v0[2], gb[3] * v0[3]), pk2(gb[4] * v1[0], gb[5] * v1[1]), pk2(gb[6] * v1[2], gb[7] * v1[3])};
            *(u32x4*)(Q.P + (size_t)row * LDP + col) = o;
          }
        }
      }
    }
    return u.sub == 0;
  }
};
__device__ void phase3a(const Params& P, char* smem) {
  g8::Job g; g.A0 = P.P + GG; g.A1 = P.P + RG; g.B0 = P.Wupg; g.B1 = P.Wupr; g.lda = LDP; g.K = 1024;
  g8::Order S; S.init(64, 4, (int)gridDim.x, (int)blockIdx.x, 2);
  Epi3a E; E.P = &P;
  g8::Unit u; const bool has = S.next(0, u);
  if (has) blk_wait(P.ctr + C_BD + (u.pm >> 3), 20u);
  g8::gemm_phase((G8_LAS unsigned char*)smem, g, S, E);
  if (has) blk_publish(P.ctr + C_PA + u.pm);
  if (blockIdx.x < 256) {
    blk_wait(P.ctr + C_QO, gridDim.x);
    const int r0 = TP + (blockIdx.x >> 6) * 32, c0 = (blockIdx.x & 63) * 16, tid = threadIdx.x;
    const float ua = mini_gemm(P.P + GG, LDP, P.Wupg, 1024, r0, c0, (float*)smem);
    const float ub = mini_gemm(P.P + RG, LDP, P.Wupr, 1024, r0, c0, (float*)smem);
    const int row = r0 + (tid >> 4), col = c0 + (tid & 15);
    const float m = bf2f(P.SG[(size_t)row * 2048 + col]) * ua + bf2f(P.SG[(size_t)row * 2048 + 1024 + col]) * ub;
    P.P[(size_t)row * LDP + col] = f2bf(m);
    blk_publish(P.ctr + C_SA);
  }
}
struct Epi3b {
  const Params* P;
  DI bool operator()(f32x4 (&acc)[2][2][4][2], const g8::Unit& u, int wr, int wc, int fr, int fq) const {
    const Params& Q = *P;
#pragma unroll
    for (int ai = 0; ai < 2; ++ai) {
      f32x4 xv[4][2][2];
#pragma unroll
      for (int m = 0; m < 4; ++m)
#pragma unroll
        for (int bj = 0; bj < 2; ++bj) {
          const int row = u.pm * 256 + ai * 128 + wr * 64 + m * 16 + fr, col = u.pn * 256 + bj * 128 + wc * 32 + 8 * fq;
          const float* xr = Q.x_prompt + (size_t)row * 1024 + col;
          xv[m][bj][0] = *(const f32x4*)xr; xv[m][bj][1] = *(const f32x4*)(xr + 4); }
#pragma unroll
      for (int m = 0; m < 4; ++m)
#pragma unroll
        for (int bj = 0; bj < 2; ++bj) {
          const int row = u.pm * 256 + ai * 128 + wr * 64 + m * 16 + fr, col = u.pn * 256 + bj * 128 + wc * 32 + 8 * fq;
          const f32x4 z0 = acc[ai][bj][m][0] + xv[m][bj][0] * 1.189207115002721f, z1 = acc[ai][bj][m][1] + xv[m][bj][1] * 1.189207115002721f;
          u32x4 o = {pk2(z0[0], z0[1]), pk2(z0[2], z0[3]), pk2(z1[0], z1[1]), pk2(z1[2], z1[3])};
          *(u32x4*)((bf16_t*)(Q.out + O_YP + (size_t)row * 1024) + col) = o; }
    }
    return false;
  }
};
DI void ln_row(const Params& P, int row, int lane) {
  float* yr = P.out + O_YP + (size_t)row * 1024;
  const u32x4 r0 = *(const u32x4*)((const bf16_t*)yr + lane * 8), r1 = *(const u32x4*)((const bf16_t*)yr + 512 + lane * 8);
  float v[16]; { float a[8], b[8]; unpack8(r0, a); unpack8(r1, b);
#pragma unroll
    for (int e = 0; e < 8; ++e) { v[e] = a[e]; v[8 + e] = b[e]; } }
  float s = 0.f;
#pragma unroll
  for (int e = 0; e < 16; ++e) s += v[e];
  const float mean = red64(s) * (1.f / 1024.f); float qq = 0.f;
#pragma unroll
  for (int e = 0; e < 16; ++e) { v[e] -= mean; qq += v[e] * v[e]; }
  const float rs = rsqrtf(red64(qq) * (1.f / 1024.f) + 1e-5f);
#pragma unroll
  for (int q = 0; q < 2; ++q)
#pragma unroll
    for (int hh = 0; hh < 2; ++hh) { const int col = q * 512 + lane * 8 + hh * 4;
      const f32x4 g = *(const f32x4*)(P.ln_g + col), bb = *(const f32x4*)(P.ln_b + col);
      f32x4 x = {v[q * 8 + hh * 4], v[q * 8 + hh * 4 + 1], v[q * 8 + hh * 4 + 2], v[q * 8 + hh * 4 + 3]};
      *(f32x4*)(yr + col) = x * rs * g + bb; }
}
__device__ void phase3bc(const Params& P, char* smem) {
  g8::Job g; g.A0 = P.P; g.A1 = P.P; g.B0 = P.Wout; g.B1 = P.Wout; g.lda = LDP; g.K = 1024;
  g8::Order S; S.init(64, 4, (int)gridDim.x, (int)blockIdx.x, 1);
  Epi3b E; E.P = &P;
  g8::Unit u; const bool has = S.next(0, u);
  if (has) blk_wait(P.ctr + C_PA + u.pm, 4u);
  g8::gemm_phase((G8_LAS unsigned char*)smem, g, S, E);
  if (has) blk_publish(P.ctr + C_PB + u.pm);
  if (blockIdx.x < 256) {
    blk_wait(P.ctr + C_SA, 256u);
    const int r0 = TP + (blockIdx.x >> 6) * 32, c0 = (blockIdx.x & 63) * 16, tid = threadIdx.x;
    const float v = mini_gemm(P.P, LDP, P.Wout, 1024, r0, c0, (float*)smem);
    const int row = r0 + (tid >> 4), col = c0 + (tid & 15);
    ((bf16_t*)(P.out + O_YP + (size_t)row * 1024))[col] = f2bf(v + 1.189207115002721f * P.x_sample[(size_t)(row - TP) * 1024 + col]);
    blk_publish(P.ctr + C_SB);
  }
  const int tid = tid_(), lane = tid & 63, wid = tid >> 6;
  if (has) {
    blk_wait(P.ctr + C_PB + u.pm, 4u);
    for (int i = 0; i < 8; ++i) ln_row(P, u.pm * 256 + u.pn * 64 + wid * 8 + i, lane);
  }
  if (blockIdx.x < 16) {
    blk_wait(P.ctr + C_SB, 256u);
    ln_row(P, TP + blockIdx.x * 8 + wid, lane);
  }
}
__device__ void phase3b(const Params& P, char* smem) { phase3bc(P, smem); }
__device__ void phase3c(const Params& P) {}

DI void grid_bar(unsigned* cnt, unsigned target) {
  asm volatile("s_waitcnt vmcnt(0) lgkmcnt(0)" ::: "memory");
  __syncthreads();
  if (threadIdx.x == 0) {
    __builtin_amdgcn_fence(__ATOMIC_RELEASE, "agent");
    asm volatile("s_waitcnt vmcnt(0)" ::: "memory");
    __hip_atomic_fetch_add(cnt, 1u, __ATOMIC_RELAXED, __HIP_MEMORY_SCOPE_AGENT);
    while (__hip_atomic_load(cnt, __ATOMIC_RELAXED, __HIP_MEMORY_SCOPE_AGENT) < target) __builtin_amdgcn_s_sleep(2);
    __builtin_amdgcn_fence(__ATOMIC_ACQUIRE, "agent");
    asm volatile("s_waitcnt vmcnt(0)" ::: "memory");
  }
  __syncthreads();
}

#if ONE_LAUNCH
__global__ void __launch_bounds__(NT) fwd_megakernel(Params P) {
  extern __shared__ __attribute__((aligned(16))) char smem[];
  cg::grid_group grid = cg::this_grid();
  const unsigned nb = gridDim.x;
  phase0(P, smem); grid.sync();
  phase1(P, smem); grid_bar(P.ctr + 64, nb);
#ifdef PROBE_ROLES
  phase2(P, smem, PROBE_ROLES, true); grid_bar(P.ctr + 64, 2 * nb);
  phase2(P, smem, 7, false); grid_bar(P.ctr + 64, 3 * nb);
  phase3a(P, smem); grid_bar(P.ctr + 64, 4 * nb);
  phase3b(P, smem); grid_bar(P.ctr + 64, 5 * nb);
  phase3c(P);
  return;
#endif
  phase2(P, smem, 7, false);
  phase3a(P, smem);
  phase3bc(P, smem);
}
#else
__global__ void __launch_bounds__(NT) k_phase0(Params P) { extern __shared__ __attribute__((aligned(16))) char smem[]; phase0(P, smem); }
__global__ void __launch_bounds__(NT) k_phase1(Params P) { extern __shared__ __attribute__((aligned(16))) char smem[]; phase1(P, smem); }
__global__ void __launch_bounds__(NT) k_phase2(Params P) { extern __shared__ __attribute__((aligned(16))) char smem[]; phase2(P, smem, 7, false); }
__global__ void __launch_bounds__(NT) k_phase3a(Params P) { extern __shared__ __attribute__((aligned(16))) char smem[]; phase3a(P, smem); }
__global__ void __launch_bounds__(NT) k_phase3b(Params P) { extern __shared__ __attribute__((aligned(16))) char smem[]; phase3b(P, smem); }
__global__ void __launch_bounds__(NT) k_phase3c(Params P) { phase3c(P); }
#endif

extern "C" void kernel_launch(void* const* d_in, const int* in_sizes, int n_in, void* d_out, int out_size, void* d_ws, size_t ws_size,
                              hipStream_t stream) {
  Params P{};
  const float* const* in = (const float* const*)d_in;
  P.x_prompt = in[0]; P.x_sample = in[1]; P.state_gla = in[2]; P.state_rwkv = in[3]; P.state_shift = in[4]; P.w_in = in[5];
  P.gla_w2 = in[6]; P.gla_b = in[7]; P.gla_nw = in[8]; P.mu = in[9]; P.w0 = in[10]; P.w2 = in[11]; P.a0 = in[12]; P.a2 = in[13];
  P.k_k = in[14]; P.k_a = in[15]; P.r_k = in[16]; P.lnx_w = in[17]; P.lnx_b = in[18]; P.w_upg = in[19]; P.w_upr = in[20]; P.w_out = in[21];
  P.ln_g = in[22]; P.ln_b = in[23];
  P.out = (float*)d_out;
  char* ws = (char*)d_ws;
  P.P = (bf16_t*)ws;
  const size_t psz = (size_t)(TT + 128) * LDP * 2;
  P.Wupg = (bf16_t*)(ws + psz); P.Wupr = P.Wupg + 1024 * 1024; P.Wout = P.Wupr + 1024 * 1024;
  P.ctr = (unsigned*)(P.Wout + 1024 * 1024);
  P.xb = (bf16_t*)((float*)d_out + O_GLAS);
  P.Wtin = P.xb + (size_t)(TT + 128) * 1024;
  P.SG = (bf16_t*)d_out;
#if ONE_LAUNCH
  static int grid_blocks = 0;
  if (!grid_blocks) {
    hipFuncSetAttribute((const void*)fwd_megakernel, hipFuncAttributeMaxDynamicSharedMemorySize, SMEM_BYTES);
    int dev = 0, cus = 0, per_cu = 0;
    hipGetDevice(&dev);
    hipDeviceGetAttribute(&cus, hipDeviceAttributeMultiprocessorCount, dev);
    hipOccupancyMaxActiveBlocksPerMultiprocessor(&per_cu, fwd_megakernel, NT, SMEM_BYTES);
    if (per_cu < 1) per_cu = 1;
    grid_blocks = cus;
    if (grid_blocks < 192) grid_blocks = 192;
  }
  void* args[] = {&P};
  hipError_t e = hipLaunchCooperativeKernel((const void*)fwd_megakernel, dim3(grid_blocks), dim3(NT), args, SMEM_BYTES, stream);
  if (e != hipSuccess) fprintf(stderr, "cooperative launch failed: %s (grid %d)\n", hipGetErrorString(e), grid_blocks);
#else
  static bool init = false;
  if (!init) { init = true;
    hipFuncSetAttribute((const void*)k_phase0, hipFuncAttributeMaxDynamicSharedMemorySize, SMEM_BYTES);
    hipFuncSetAttribute((const void*)k_phase1, hipFuncAttributeMaxDynamicSharedMemorySize, SMEM_BYTES);
    hipFuncSetAttribute((const void*)k_phase2, hipFuncAttributeMaxDynamicSharedMemorySize, SMEM_BYTES);
    hipFuncSetAttribute((const void*)k_phase3a, hipFuncAttributeMaxDynamicSharedMemorySize, SMEM_BYTES);
    hipFuncSetAttribute((const void*)k_phase3b, hipFuncAttributeMaxDynamicSharedMemorySize, SMEM_BYTES);
  }
  k_phase0<<<256, NT, SMEM_BYTES, stream>>>(P);
  k_phase1<<<256, NT, SMEM_BYTES, stream>>>(P);
  k_phase2<<<256, NT, SMEM_BYTES, stream>>>(P);
  k_phase3a<<<256, NT, SMEM_BYTES, stream>>>(P);
  k_phase3b<<<256, NT, SMEM_BYTES, stream>>>(P);
  k_phase3c<<<256, NT, 0, stream>>>(P);
#endif
}
```
